# Optimizing an MI355X kernel written in HIP

```python
import jax, jax.numpy as jnp
from jax import lax
import numpy as np

D_MODEL = 1024
BATCH = 2
SEQ = 8192
DEPTH = 1
DEC_BATCH = 16
DEC_SEQ = 64
PAST_LEN = 1024

CHUNK = 64
N_HEADS = 8
HEAD_DIM = 64
D_ATTN = N_HEADS * HEAD_DIM
D_RNN = 512
N_RNN_BLOCKS = 8
RNN_BLOCK = D_RNN // N_RNN_BLOCKS
CONV_WIDTH = 4
LRU_C = 8.0
D_FF = 4 * D_MODEL
Q_BLOCK = 128
EPS = 1e-6
SPLITS = (D_ATTN, 2 * D_ATTN, 3 * D_ATTN, 3 * D_ATTN + D_RNN, 3 * D_ATTN + 2 * D_RNN,
          3 * D_ATTN + 2 * D_RNN + D_MODEL)
D_IN = 3 * D_ATTN + 2 * D_RNN + 2 * D_MODEL

kernel_name = "hybrid_stickbreak_rglru_stream_step"


def rms_norm(x, g):
    xf = x.astype(jnp.float32)
    y = xf * lax.rsqrt(jnp.mean(xf * xf, axis=-1, keepdims=True) + EPS)
    return (y * g.astype(jnp.float32)).astype(x.dtype)


def _sb_block(q, k, v, q_pos, k_pos):
    z = jnp.einsum("bqhd,bkhd->bhqk", q, k).astype(jnp.float32) * (HEAD_DIM ** -0.5)
    causal = k_pos[None, :] < q_pos[:, None]
    log_keep = jnp.where(causal, jax.nn.log_sigmoid(-z), 0.0)
    rev = lax.cumsum(log_keep, axis=3, reverse=True)
    after = jnp.concatenate([rev[..., 1:], jnp.zeros_like(rev[..., :1])], axis=-1)
    w = jnp.where(causal, jnp.exp(jax.nn.log_sigmoid(z) + after), 0.0)
    return jnp.einsum("bhqk,bkhd->bqhd", w.astype(v.dtype), v)


def stick_breaking_attention(q, k, v, past_len):
    b, tq = q.shape[0], q.shape[1]
    k_pos = jnp.arange(k.shape[1])
    q_pos = past_len + jnp.arange(tq)
    if tq <= Q_BLOCK:
        return _sb_block(q, k, v, q_pos, k_pos)
    nb = tq // Q_BLOCK
    qb = q.reshape(b, nb, Q_BLOCK, N_HEADS, HEAD_DIM).transpose(1, 0, 2, 3, 4)
    pb = q_pos.reshape(nb, Q_BLOCK)
    out = lax.map(lambda a: _sb_block(a[0], k, v, a[1], k_pos), (qb, pb))
    return out.transpose(1, 0, 2, 3, 4).reshape(b, tq, N_HEADS, HEAD_DIM)


def causal_conv(x, past, w, bias):
    xp = jnp.concatenate([past, x], axis=1)
    t = x.shape[1]
    y = bias + xp[:, 0:t] * w[0]
    for j in range(1, CONV_WIDTH):
        y = y + xp[:, j:j + t] * w[j]
    return y, xp[:, -(CONV_WIDTH - 1):]


def _lin_combine(left, right):
    a1, b1 = left
    a2, b2 = right
    return a1 * a2, a2 * b1 + b2


def rg_lru(x, h0, w_r, b_r, w_i, b_i, lam):
    b, t, _ = x.shape
    xb = x.reshape(b, t, N_RNN_BLOCKS, RNN_BLOCK)
    r = jax.nn.sigmoid(jnp.einsum("btnc,ncd->btnd", xb, w_r).reshape(b, t, D_RNN) + b_r)
    i = jax.nn.sigmoid(jnp.einsum("btnc,ncd->btnd", xb, w_i).reshape(b, t, D_RNN) + b_i)
    log_a = -LRU_C * jax.nn.softplus(-lam.astype(jnp.float32)) * r.astype(jnp.float32)
    a = jnp.exp(log_a)
    u = jnp.sqrt(-jnp.expm1(2.0 * log_a)) * (i * x).astype(jnp.float32)
    a_cum, h = lax.associative_scan(_lin_combine, (a, u), axis=1)
    h = h + a_cum * h0[:, None, :].astype(jnp.float32)
    return h.astype(x.dtype), h[:, -1].astype(x.dtype)


def hybrid_layer(x, k_past, v_past, conv_past, h_past, w_in, g_pre_mix, w_conv, b_conv,
                 w_r, b_r, w_i, b_i, lam, w_a_out, w_b_out, w_o, g_post_mix,
                 g_pre_ffn, w_up, w_down, g_post_ffn):
    b, t, _ = x.shape
    past_len = k_past.shape[1]
    xn = rms_norm(x, g_pre_mix)
    proj = xn @ w_in
    q, k, v, u, g_rnn, g_a, g_b = jnp.split(proj, list(SPLITS), axis=-1)
    q = q.reshape(b, t, N_HEADS, HEAD_DIM)
    k = k.reshape(b, t, N_HEADS, HEAD_DIM)
    v = v.reshape(b, t, N_HEADS, HEAD_DIM)
    k_all = jnp.concatenate([k_past, k], axis=1)
    v_all = jnp.concatenate([v_past, v], axis=1)
    o = stick_breaking_attention(q, k_all, v_all, past_len)
    y_a = o.reshape(b, t, D_ATTN) @ w_a_out
    uc, conv_new = causal_conv(u, conv_past, w_conv, b_conv)
    hseq, h_last = rg_lru(uc, h_past, w_r, b_r, w_i, b_i, lam)
    y_b = (hseq * jax.nn.gelu(g_rnn)) @ w_b_out
    mix = (jax.nn.sigmoid(g_a) * y_a + jax.nn.sigmoid(g_b) * y_b) @ w_o
    x = x + rms_norm(mix, g_post_mix)
    hf = jnp.square(jax.nn.relu(rms_norm(x, g_pre_ffn) @ w_up))
    x = x + rms_norm(hf @ w_down, g_post_ffn)
    return x, k, v, conv_new, h_last


def setup_inputs(seed: int = 0) -> dict:
    key = jax.random.key(seed)
    ks = jax.random.split(key, 32)
    f32 = jnp.float32
    L = DEPTH

    def nrm(k, shape, scale):
        return jax.random.normal(k, shape, f32) * scale

    u = jax.random.uniform(ks[14], (L, D_RNN), f32, 0.9, 0.999)
    s = u ** (1.0 / LRU_C)
    lam = jnp.log(s) - jnp.log1p(-s)
    return {
        "x_prompt": nrm(ks[0], (BATCH, SEQ, D_MODEL), 1.0),
        "x_sample": nrm(ks[1], (DEC_BATCH, DEC_SEQ, D_MODEL), 1.0),
        "cache_k": nrm(ks[2], (L, DEC_BATCH, PAST_LEN, N_HEADS, HEAD_DIM), 1.0),
        "cache_v": nrm(ks[3], (L, DEC_BATCH, PAST_LEN, N_HEADS, HEAD_DIM), 1.0),
        "state_conv": nrm(ks[4], (L, DEC_BATCH, CONV_WIDTH - 1, D_RNN), 1.0),
        "state_h": nrm(ks[5], (L, DEC_BATCH, D_RNN), 0.5),
        "w_in": nrm(ks[6], (L, D_MODEL, D_IN), D_MODEL ** -0.5),
        "g_pre_mix": 1.0 + nrm(ks[7], (L, D_MODEL), 0.01),
        "w_conv": nrm(ks[8], (L, CONV_WIDTH, D_RNN), CONV_WIDTH ** -0.5),
        "b_conv": nrm(ks[9], (L, D_RNN), 0.01),
        "w_r": nrm(ks[10], (L, N_RNN_BLOCKS, RNN_BLOCK, RNN_BLOCK), RNN_BLOCK ** -0.5),
        "b_r": nrm(ks[11], (L, D_RNN), 0.01),
        "w_i": nrm(ks[12], (L, N_RNN_BLOCKS, RNN_BLOCK, RNN_BLOCK), RNN_BLOCK ** -0.5),
        "b_i": nrm(ks[13], (L, D_RNN), 0.01),
        "lam": lam,
        "w_a_out": nrm(ks[15], (L, D_ATTN, D_MODEL), D_ATTN ** -0.5),
        "w_b_out": nrm(ks[16], (L, D_RNN, D_MODEL), D_RNN ** -0.5),
        "w_o": nrm(ks[17], (L, D_MODEL, D_MODEL), D_MODEL ** -0.5),
        "g_post_mix": 1.0 + nrm(ks[18], (L, D_MODEL), 0.01),
        "g_pre_ffn": 1.0 + nrm(ks[19], (L, D_MODEL), 0.01),
        "w_up": nrm(ks[20], (L, D_MODEL, D_FF), D_MODEL ** -0.5),
        "w_down": nrm(ks[21], (L, D_FF, D_MODEL), D_FF ** -0.5),
        "g_post_ffn": 1.0 + nrm(ks[22], (L, D_MODEL), 0.01),
    }


def reference(x_prompt, x_sample, cache_k, cache_v, state_conv, state_h, w_in, g_pre_mix,
              w_conv, b_conv, w_r, b_r, w_i, b_i, lam, w_a_out, w_b_out, w_o, g_post_mix,
              g_pre_ffn, w_up, w_down, g_post_ffn):
    dt = x_prompt.dtype
    kp0 = jnp.zeros((BATCH, 0, N_HEADS, HEAD_DIM), dt)
    cp0 = jnp.zeros((BATCH, CONV_WIDTH - 1, D_RNN), dt)
    hp0 = jnp.zeros((BATCH, D_RNN), dt)
    xp, xs = x_prompt, x_sample
    kps, vps, cps, hps, kss, vss, css, hss = [], [], [], [], [], [], [], []
    for l in range(DEPTH):
        wl = (w_in[l], g_pre_mix[l], w_conv[l], b_conv[l], w_r[l], b_r[l], w_i[l], b_i[l],
              lam[l], w_a_out[l], w_b_out[l], w_o[l], g_post_mix[l], g_pre_ffn[l],
              w_up[l], w_down[l], g_post_ffn[l])
        xp, kp, vp, cp, hp = hybrid_layer(xp, kp0, kp0, cp0, hp0, *wl)
        xs, ksn, vsn, csn, hsn = hybrid_layer(xs, cache_k[l], cache_v[l], state_conv[l],
                                              state_h[l], *wl)
        kps.append(kp); vps.append(vp); cps.append(cp); hps.append(hp)
        kss.append(ksn); vss.append(vsn); css.append(csn); hss.append(hsn)
    return (xp, xs, jnp.stack(kps), jnp.stack(vps), jnp.stack(cps), jnp.stack(hps),
            jnp.stack(kss), jnp.stack(vss), jnp.stack(css), jnp.stack(hss))
```

```cpp
#include <hip/hip_runtime.h>
#include <hip/hip_cooperative_groups.h>
#include <cstdio>
#include <cstdint>
namespace cg = cooperative_groups;
namespace pg8 {
#define PG8_LAS __attribute__((address_space(3)))
typedef unsigned short bf16_t;
typedef short bf16x8 __attribute__((ext_vector_type(8)));
typedef float f32x4 __attribute__((ext_vector_type(4)));
typedef unsigned u32x4 __attribute__((ext_vector_type(4)));
constexpr int BM = 256, BK = 64, HALF = 128, HTB = HALF * BK * 2  , STAGE_BYTES = 8 * HTB, NXCD = 8, WGM = 8;

__host__ __device__ __forceinline__ int lds_byte(int r, int c) { const int st = (r >> 4) * 2 + (c >> 5), rr = r & 15, cc = c & 31, ob = rr * 64 + cc * 2; return st * 1024 + (ob ^ (((ob >> 9) & 1) << 5)); }
__host__ __device__ __forceinline__ void stage_rc(int b, int& R, int& C) { const int st = b / 1024, sb = b % 1024, swz = sb ^ (((sb >> 9) & 1) << 5); R = (st >> 1) * 16 + swz / 64; C = (st & 1) * 32 + (swz % 64) / 2; }
__host__ __device__ __forceinline__ int perm32(int rho) { const int n = rho >> 4, i = rho & 15; return 8 * (i >> 2) + 4 * n + (i & 3); }

struct Unit { int pm, pn; };
struct Gemm { const bf16_t* A; const bf16_t* Bt; int M, N, K, lda; };

struct StaticOrder {
    int nM, nN, nwg, G, c;
    __host__ __device__ void init(int M, int N, int G_, int c_) { nM = M / BM; nN = N / BM; nwg = nM * nN; G = G_; c = c_; }
    __host__ __device__ bool next(int i, Unit& u) const {
        const long L = (long)i * G + c; if (L >= nwg) return false;
        int wgid = (int)L; { const int q = nwg / NXCD, r = nwg % NXCD, xcd = wgid % NXCD, off = wgid / NXCD; wgid = (xcd < r ? xcd * (q + 1) : r * (q + 1) + (xcd - r) * q) + off; }
        const int nig = WGM * nN, gid = wgid / nig, fm = gid * WGM, gsz = (nM - fm) < WGM ? (nM - fm) : WGM;
        u.pm = fm + ((wgid % nig) % gsz); u.pn = (wgid % nig) / gsz; return true;
    }
    __device__ __forceinline__ void a_ready(const Unit&) const {}
    __device__ __forceinline__ void done(const Unit&) const {}
};

__device__ __forceinline__ unsigned cvt_pk_bf16(float lo, float hi) { unsigned r; asm volatile("v_cvt_pk_bf16_f32 %0, %1, %2" : "=v"(r) : "v"(lo), "v"(hi)); return r; }
__device__ __forceinline__ float bf_lo(unsigned w) { return __uint_as_float(w << 16); }
__device__ __forceinline__ float bf_hi(unsigned w) { return __uint_as_float(w & 0xffff0000u); }
__device__ __forceinline__ float sigmoidf_(float x) { return __builtin_amdgcn_rcpf(1.0f + __builtin_amdgcn_exp2f(-1.4426950408889634f * x)); }
constexpr int PROJ_LD = 4608;
constexpr size_t OFF_Y = 0, OFF_KP = 17825792, OFF_VP = 26214400, OFF_CP = 34603008, OFF_HP = 34606080, OFF_KS = 34607104, OFF_VS = 35131392, OFF_CS = 35655680, OFF_HS = 35680256, OUT_TOTAL = 35688448;

struct EpiProj {
    static constexpr bool PERM = true, AFTER_DRAIN = false;
    bf16_t* P; float* out;
    __device__ __forceinline__ void operator()(const f32x4 (&acc)[2][2][4][2], const Unit& u, int wr, int wc, int fr, int fq) const {
        const int row0 = u.pm * BM + wr * 64 + fr, col0 = u.pn * BM + wc * 32 + 8 * fq;
        const bool iskv = (u.pn >= 2 && u.pn < 6), isv = u.pn >= 4, samp = u.pm >= 64;
        float* kvb = out + (samp ? (isv ? OFF_VS : OFF_KS) : (isv ? OFF_VP : OFF_KP)) - (samp ? (size_t)16384 * 512 : 0) + (col0 - (isv ? 1024 : 512));
#pragma unroll
        for (int ai = 0; ai < 2; ++ai)
#pragma unroll
            for (int m = 0; m < 4; ++m) { const int row = row0 + ai * HALF + m * 16; bf16_t* rowp = P + (size_t)row * PROJ_LD + col0;
#pragma unroll
                for (int bj = 0; bj < 2; ++bj) { const f32x4 v0 = acc[ai][bj][m][0], v1 = acc[ai][bj][m][1];
                    u32x4 w; w.x = cvt_pk_bf16(v0[0], v0[1]); w.y = cvt_pk_bf16(v0[2], v0[3]); w.z = cvt_pk_bf16(v1[0], v1[1]); w.w = cvt_pk_bf16(v1[2], v1[3]);
                    *(u32x4*)(rowp + bj * HALF) = w;
                    if (iskv) { float* d = kvb + (size_t)row * 512 + bj * HALF; *(f32x4*)d = v0; *(f32x4*)(d + 4) = v1; } } }
    }
};
template <int MODE  > struct EpiGate {
    static constexpr bool PERM = true, AFTER_DRAIN = false;
    bf16_t* Y; const bf16_t* P;
    __device__ __forceinline__ void operator()(const f32x4 (&acc)[2][2][4][2], const Unit& u, int wr, int wc, int fr, int fq) const {
        const int row0 = u.pm * BM + wr * 64 + fr, col0 = u.pn * BM + wc * 32 + 8 * fq;
#pragma unroll
        for (int ai = 0; ai < 2; ++ai)
#pragma unroll
            for (int m = 0; m < 4; ++m) { const int row = row0 + ai * HALF + m * 16; bf16_t* rowp = Y + (size_t)row * 1024 + col0; const bf16_t* gp = P + (size_t)row * PROJ_LD + (MODE == 0 ? 2560 : 3584) + col0;
#pragma unroll
                for (int bj = 0; bj < 2; ++bj) { const f32x4 v0 = acc[ai][bj][m][0], v1 = acc[ai][bj][m][1];
                    const u32x4 g = *(const u32x4*)(gp + bj * HALF);
                    float o[8] = { sigmoidf_(bf_lo(g.x)) * v0[0], sigmoidf_(bf_hi(g.x)) * v0[1], sigmoidf_(bf_lo(g.y)) * v0[2], sigmoidf_(bf_hi(g.y)) * v0[3],
                                   sigmoidf_(bf_lo(g.z)) * v1[0], sigmoidf_(bf_hi(g.z)) * v1[1], sigmoidf_(bf_lo(g.w)) * v1[2], sigmoidf_(bf_hi(g.w)) * v1[3] };
                    if (MODE == 1) { const u32x4 y = *(const u32x4*)(rowp + bj * HALF);
                        o[0] += bf_lo(y.x); o[1] += bf_hi(y.x); o[2] += bf_lo(y.y); o[3] += bf_hi(y.y); o[4] += bf_lo(y.z); o[5] += bf_hi(y.z); o[6] += bf_lo(y.w); o[7] += bf_hi(y.w); }
                    u32x4 w; w.x = cvt_pk_bf16(o[0], o[1]); w.y = cvt_pk_bf16(o[2], o[3]); w.z = cvt_pk_bf16(o[4], o[5]); w.w = cvt_pk_bf16(o[6], o[7]);
                    *(u32x4*)(rowp + bj * HALF) = w; } }
    }
};
struct EpiF32 {
    static constexpr bool PERM = true, AFTER_DRAIN = false;
    float* O; int ldc;
    __device__ __forceinline__ void operator()(const f32x4 (&acc)[2][2][4][2], const Unit& u, int wr, int wc, int fr, int fq) const {
        const int row0 = u.pm * BM + wr * 64 + fr, col0 = u.pn * BM + wc * 32 + 8 * fq;
#pragma unroll
        for (int ai = 0; ai < 2; ++ai)
#pragma unroll
            for (int m = 0; m < 4; ++m) { float* rowp = O + (size_t)(row0 + ai * HALF + m * 16) * ldc + col0;
#pragma unroll
                for (int bj = 0; bj < 2; ++bj) { *(f32x4*)(rowp + bj * HALF) = acc[ai][bj][m][0]; *(f32x4*)(rowp + bj * HALF + 4) = acc[ai][bj][m][1]; } }
    }
};
struct EpiRelu2 {
    static constexpr bool PERM = true, AFTER_DRAIN = false;
    bf16_t* O; int ldc;
    __device__ __forceinline__ void operator()(const f32x4 (&acc)[2][2][4][2], const Unit& u, int wr, int wc, int fr, int fq) const {
        const int row0 = u.pm * BM + wr * 64 + fr, col0 = u.pn * BM + wc * 32 + 8 * fq;
#pragma unroll
        for (int ai = 0; ai < 2; ++ai)
#pragma unroll
            for (int m = 0; m < 4; ++m) { bf16_t* rowp = O + (size_t)(row0 + ai * HALF + m * 16) * ldc + col0;
#pragma unroll
                for (int bj = 0; bj < 2; ++bj) { f32x4 v0 = acc[ai][bj][m][0], v1 = acc[ai][bj][m][1];
#pragma unroll
                    for (int e = 0; e < 4; ++e) { const float a = fmaxf(v0[e], 0.f), b = fmaxf(v1[e], 0.f); v0[e] = a * a; v1[e] = b * b; }
                    u32x4 w; w.x = cvt_pk_bf16(v0[0], v0[1]); w.y = cvt_pk_bf16(v0[2], v0[3]); w.z = cvt_pk_bf16(v1[0], v1[1]); w.w = cvt_pk_bf16(v1[2], v1[3]);
                    *(u32x4*)(rowp + bj * HALF) = w; } }
    }
};
template <class Epi, class Sched, bool ALIGN_EPI = false, bool SP2 = false>
__device__ __forceinline__ void gemm_phase(PG8_LAS unsigned char* lds, const Gemm g, const Sched& S, const Epi& E) {
    const int tid = threadIdx.x, wid = __builtin_amdgcn_readfirstlane(tid >> 6), lane = tid & 63, wr = wid >> 2, wc = wid & 3, fr = lane & 15, fq = lane >> 4;
    const int K = g.K, nt = K / BK;
    unsigned voffA[2], voffB[2];
#pragma unroll
    for (int i = 0; i < 2; ++i) { int R, C; stage_rc(tid * 16 + i * 8192, R, C); const int Rb = Epi::PERM ? ((R & ~31) + perm32(R & 31)) : R;
        voffA[i] = (unsigned)(R * g.lda + C) * 2u; voffB[i] = (unsigned)(Rb * K + C) * 2u; }
    const size_t kstep = (size_t)(BK * 2);
    const size_t hstepA = (size_t)HALF * g.lda * 2, hstepB = (size_t)HALF * K * 2;
    const size_t tstepA = 2 * hstepA, tstepB = 2 * hstepB;
    const unsigned ldsw = (unsigned)wid * 1024u;
    const int aoff = lds_byte(wr * 64 + fr, fq * 8), boff = lds_byte(wc * 32 + fr, fq * 8);
#define PG8_SA(b, h) (((b) * 2 + (h)) * HTB)
#define PG8_SB(b, h) ((4 + (b) * 2 + (h)) * HTB)
#define PG8_STAGE(bufoff, gbase, voff) do { _Pragma("unroll") for (int _i = 0; _i < 2; ++_i) \
        __builtin_amdgcn_global_load_lds((const unsigned*)((const char*)(gbase) + (voff)[_i]), (PG8_LAS unsigned*)(lds + (bufoff) + ldsw + _i * 8192), 16, 0, 0); } while (0)
#define PG8_LDA(dst, b, h) do { _Pragma("unroll") for (int m = 0; m < 4; ++m) _Pragma("unroll") for (int k = 0; k < 2; ++k) dst[m][k] = *(const PG8_LAS bf16x8*)(lds + PG8_SA(b, h) + aoff + m * 2048 + k * 1024); } while (0)
#define PG8_LDB(dst, b, h) do { _Pragma("unroll") for (int n = 0; n < 2; ++n) _Pragma("unroll") for (int k = 0; k < 2; ++k) dst[n][k] = *(const PG8_LAS bf16x8*)(lds + PG8_SB(b, h) + boff + n * 2048 + k * 1024); } while (0)
#define PG8_MMA(ai, bj, At, Bt) do { __builtin_amdgcn_s_setprio(1); _Pragma("unroll") for (int m = 0; m < 4; ++m) _Pragma("unroll") for (int n = 0; n < 2; ++n) _Pragma("unroll") for (int k = 0; k < 2; ++k) \
        acc[ai][bj][m][n] = __builtin_amdgcn_mfma_f32_16x16x32_bf16(Bt[n][k], At[m][k], acc[ai][bj][m][n], 0, 0, 0); __builtin_amdgcn_s_setprio(0); } while (0)
#define PG8_WAIT_V(n) asm volatile("s_waitcnt vmcnt(" #n ")" ::: "memory")
#define PG8_WAIT_L(n) asm volatile("s_waitcnt lgkmcnt(" #n ")" ::: "memory")
#define PG8_BAR __builtin_amdgcn_s_barrier()
#define PG8_SCHED __builtin_amdgcn_sched_barrier(0)
    Unit cur, nxt; int ui = 0;
    if (!S.next(0, cur)) return;
    f32x4 acc[2][2][4][2];
#pragma unroll
    for (int a = 0; a < 2; ++a)
#pragma unroll
        for (int b = 0; b < 2; ++b)
#pragma unroll
            for (int m = 0; m < 4; ++m)
#pragma unroll
                for (int n = 0; n < 2; ++n) acc[a][b][m][n] = (f32x4){0.f, 0.f, 0.f, 0.f};
    bf16x8 At[4][2], B0[2][2], B1[2][2];
    const char* cA = (const char*)g.A + (size_t)cur.pm * tstepA; const char* cB = (const char*)g.Bt + (size_t)cur.pn * tstepB;
    S.a_ready(cur);
    if constexpr (SP2) {
        PG8_STAGE(PG8_SB(0, 0), cB, voffB); PG8_STAGE(PG8_SB(0, 1), cB + hstepB, voffB); PG8_STAGE(PG8_SA(0, 0), cA, voffA); PG8_STAGE(PG8_SA(0, 1), cA + hstepA, voffA);
        if (wr == 1) PG8_BAR;
        PG8_WAIT_V(2); PG8_BAR;
        PG8_STAGE(PG8_SB(1, 0), cB + kstep, voffB); PG8_STAGE(PG8_SA(1, 0), cA + kstep, voffA); PG8_STAGE(PG8_SB(1, 1), cB + hstepB + kstep, voffB);
        PG8_WAIT_V(6); PG8_BAR;
    } else {
        PG8_STAGE(PG8_SB(0, 0), cB, voffB); PG8_STAGE(PG8_SA(0, 0), cA, voffA); PG8_STAGE(PG8_SB(0, 1), cB + hstepB, voffB); PG8_STAGE(PG8_SA(0, 1), cA + hstepA, voffA);
        if (wr == 1) PG8_BAR;
        PG8_WAIT_V(4); PG8_BAR;
        PG8_STAGE(PG8_SB(1, 0), cB + kstep, voffB); PG8_STAGE(PG8_SA(1, 0), cA + kstep, voffA); PG8_STAGE(PG8_SB(1, 1), cB + hstepB + kstep, voffB);
        PG8_WAIT_V(6); PG8_BAR;
    }
    for (;;) {
        const bool has_next = S.next(ui + 1, nxt);
        const char* nA = has_next ? (const char*)g.A + (size_t)nxt.pm * tstepA : cA; const char* nB = has_next ? (const char*)g.Bt + (size_t)nxt.pn * tstepB : cB;
        for (int t = 0; t < nt; t += 2) {
            const bool last = (t == nt - 2);
            const char* a1 = cA + (size_t)(t + 1) * kstep;
            const char* a2 = last ? nA : cA + (size_t)(t + 2) * kstep; const char* b2 = last ? nB : cB + (size_t)(t + 2) * kstep;
            const char* a3 = a2 + kstep; const char* b3 = b2 + kstep;
            if (last && has_next) S.a_ready(nxt);
            if constexpr (SP2) {
            PG8_LDB(B0, 0, 0); PG8_LDB(B1, 0, 1); PG8_SCHED; PG8_LDA(At, 0, 0); PG8_STAGE(PG8_SA(1, 1), a1 + hstepA, voffA);
            PG8_WAIT_V(8); PG8_WAIT_L(0); PG8_BAR; PG8_MMA(0, 0, At, B0); PG8_MMA(0, 1, At, B1); PG8_BAR; PG8_SCHED;
            PG8_LDA(At, 0, 1); PG8_STAGE(PG8_SB(0, 0), b2, voffB); PG8_STAGE(PG8_SB(0, 1), b2 + hstepB, voffB); PG8_STAGE(PG8_SA(0, 0), a2, voffA);
            PG8_WAIT_V(8); PG8_WAIT_L(0); PG8_BAR; PG8_MMA(1, 0, At, B0); PG8_MMA(1, 1, At, B1); PG8_BAR; PG8_SCHED;
            PG8_LDB(B0, 1, 0); PG8_LDB(B1, 1, 1); PG8_SCHED; PG8_LDA(At, 1, 0); PG8_STAGE(PG8_SA(0, 1), a2 + hstepA, voffA);
            PG8_WAIT_V(8); PG8_WAIT_L(0); PG8_BAR; PG8_MMA(0, 0, At, B0); PG8_MMA(0, 1, At, B1); PG8_BAR; PG8_SCHED;
            PG8_LDA(At, 1, 1); PG8_STAGE(PG8_SB(1, 0), b3, voffB); PG8_STAGE(PG8_SB(1, 1), b3 + hstepB, voffB); PG8_STAGE(PG8_SA(1, 0), a3, voffA);
            PG8_WAIT_V(8); PG8_WAIT_L(0); PG8_BAR; PG8_MMA(1, 0, At, B0); PG8_MMA(1, 1, At, B1); PG8_BAR; PG8_SCHED;
            } else {
            PG8_LDB(B0, 0, 0); PG8_SCHED; PG8_LDA(At, 0, 0); PG8_STAGE(PG8_SA(1, 1), a1 + hstepA, voffA);
            PG8_WAIT_L(8); PG8_BAR; PG8_WAIT_L(0); PG8_MMA(0, 0, At, B0); PG8_BAR; PG8_SCHED;
            PG8_LDB(B1, 0, 1); PG8_STAGE(PG8_SB(0, 0), b2, voffB);
            PG8_BAR; PG8_WAIT_L(0); PG8_MMA(0, 1, At, B1); PG8_BAR;
            PG8_LDA(At, 0, 1); PG8_STAGE(PG8_SA(0, 0), a2, voffA);
            PG8_BAR; PG8_WAIT_L(0); PG8_MMA(1, 0, At, B0); PG8_BAR; PG8_SCHED;
            PG8_STAGE(PG8_SB(0, 1), b2 + hstepB, voffB);
            PG8_WAIT_V(6); PG8_BAR; PG8_MMA(1, 1, At, B1); PG8_BAR;
            PG8_LDB(B0, 1, 0); PG8_SCHED; PG8_LDA(At, 1, 0); PG8_STAGE(PG8_SA(0, 1), a2 + hstepA, voffA);
            PG8_WAIT_L(8); PG8_BAR; PG8_WAIT_L(0); PG8_MMA(0, 0, At, B0); PG8_BAR; PG8_SCHED;
            PG8_LDB(B1, 1, 1); PG8_STAGE(PG8_SB(1, 0), b3, voffB);
            PG8_BAR; PG8_WAIT_L(0); PG8_MMA(0, 1, At, B1); PG8_BAR;
            PG8_LDA(At, 1, 1); PG8_STAGE(PG8_SA(1, 0), a3, voffA);
            PG8_BAR; PG8_WAIT_L(0); PG8_MMA(1, 0, At, B0); PG8_BAR; PG8_SCHED;
            PG8_STAGE(PG8_SB(1, 1), b3 + hstepB, voffB);
            PG8_WAIT_V(6); PG8_BAR; PG8_MMA(1, 1, At, B1); PG8_BAR;
            }
        }
        if constexpr (ALIGN_EPI) { if (wr == 0) PG8_BAR; }
        if constexpr (!Epi::AFTER_DRAIN) { E(acc, cur, wr, wc, fr, fq); S.done(cur); }
        if (!has_next) break;
#pragma unroll
        for (int a = 0; a < 2; ++a)
#pragma unroll
            for (int b = 0; b < 2; ++b)
#pragma unroll
                for (int m = 0; m < 4; ++m)
#pragma unroll
                    for (int n = 0; n < 2; ++n) acc[a][b][m][n] = (f32x4){0.f, 0.f, 0.f, 0.f};
        cur = nxt; cA = nA; cB = nB; ++ui;
        if constexpr (ALIGN_EPI) { if (wr == 1) PG8_BAR; }
    }
    PG8_WAIT_V(0);
    if constexpr (!ALIGN_EPI) { if (wr == 0) PG8_BAR; }
    PG8_BAR;
    if constexpr (Epi::AFTER_DRAIN) { E.fused(acc, cur, wr, wc, fr, fq, lds, wid, lane); S.done(cur); }
#undef PG8_SA
#undef PG8_SB
#undef PG8_STAGE
#undef PG8_LDA
#undef PG8_LDB
#undef PG8_MMA
#undef PG8_WAIT_V
#undef PG8_WAIT_L
#undef PG8_BAR
#undef PG8_SCHED
}
}

constexpr int NWAVES = 8;
constexpr int DM = 1024, MP = 16384, MS = 1024, M = MP + MS, DIN = 4608, DFF = 4096, SEQ = 8192, PAST = 1024, DSEQ = 64;
constexpr int C_Q = 0, C_K = 512, C_V = 1024, C_U = 1536, C_GR = 2048, C_GA = 2560, C_GB = 3584;
constexpr float EPS = 1e-6f;
constexpr float LOG2E = 1.4426950408889634f, LN2 = 0.6931471805599453f;
constexpr size_t MiB = 1u << 20;
constexpr size_t WS_CTL = 0;
constexpr size_t WS_WIN = 1 * MiB, WS_WA = 10 * MiB, WS_WB = 11 * MiB, WS_WO = 12 * MiB, WS_WUP = 14 * MiB, WS_WDN = 22 * MiB;
constexpr size_t WS_WR = 30 * MiB, WS_WI = 30 * MiB + 65536;
constexpr size_t WS_AGA = 31 * MiB, WS_AGB = 31 * MiB + 524288;
constexpr size_t WS_XN = 32 * MiB;
constexpr size_t WS_YA = 66 * MiB;
constexpr size_t WS_PROJ = 100 * MiB;
constexpr size_t WS_DOWN = WS_XN;
constexpr size_t WS_END = 253 * MiB;
constexpr int RING_BYTES = 131072, LDS_BYTES = 147456;

#define GAS __attribute__((address_space(1)))
#define LAS __attribute__((address_space(3)))
#define DI __device__ __forceinline__
typedef unsigned short bf16;
typedef unsigned v4u __attribute__((ext_vector_type(4)));
typedef float f32x4 __attribute__((ext_vector_type(4)));
typedef float f32x16 __attribute__((ext_vector_type(16)));
typedef short bf16x8 __attribute__((ext_vector_type(8)));
typedef float f32x2_t __attribute__((ext_vector_type(2))); typedef __bf16 bf16x2_t __attribute__((ext_vector_type(2)));
DI unsigned pk2(float lo, float hi) { f32x2_t v = {lo, hi}; bf16x2_t b = __builtin_convertvector(v, bf16x2_t); return __builtin_bit_cast(unsigned, b); }
DI float bf2f(unsigned short h) { return __uint_as_float((unsigned)h << 16); }
DI float blo(unsigned w) { return __uint_as_float(w << 16); }
DI float bhi(unsigned w) { return __uint_as_float(w & 0xffff0000u); }
DI int crow(int i, int h) { return (i & 3) + 8 * (i >> 2) + 4 * h; }
#define MFMA32(a, b, c) __builtin_amdgcn_mfma_f32_32x32x16_bf16((a), (b), (c), 0, 0, 0)
DI void swap32(float v, float& lo, float& hi) { auto rr = __builtin_amdgcn_permlane32_swap(__float_as_uint(v), __float_as_uint(v), false, false); lo = __uint_as_float(rr[0]); hi = __uint_as_float(rr[1]); }
DI float sigm(float x) { return __builtin_amdgcn_rcpf(1.0f + __builtin_amdgcn_exp2f(-LOG2E * x)); }
DI float wave_sum(float v) {
#pragma unroll
    for (int o = 1; o < 64; o <<= 1) v += __shfl_xor(v, o);
    return v;
}

struct Params { const float* in[23]; float* out; unsigned char* ws; };
enum { I_XP = 0, I_XS, I_CK, I_CV, I_SC, I_SH, I_WIN, I_GPM, I_WC, I_BC, I_WR, I_BR, I_WI, I_BI, I_LAM, I_WA, I_WB, I_WO, I_GPOM, I_GPF, I_WUP, I_WDN, I_GPOF };

DI void p0_transpose_item(const float* W, int K, int N, bf16* WT, LAS float* scr, int item, int lane) {
    const int nblk = N / 32, kb = item / nblk, nb = item % nblk, k0 = 64 * kb, n0 = 32 * nb;
#pragma unroll 8
    for (int i = 0; i < 32; ++i) { const int kk = 2 * i + (lane >> 5); scr[kk * 33 + (lane & 31)] = W[(size_t)(k0 + kk) * N + n0 + (lane & 31)]; }
    asm volatile("s_waitcnt lgkmcnt(0)" ::: "memory");
    const int c = lane & 7;
#pragma unroll
    for (int j = 0; j < 4; ++j) { const int n = (lane >> 3) + 8 * j; const LAS float* s = scr + (8 * c) * 33 + n;
        v4u o; o.x = pk2(s[0 * 33], s[1 * 33]); o.y = pk2(s[2 * 33], s[3 * 33]); o.z = pk2(s[4 * 33], s[5 * 33]); o.w = pk2(s[6 * 33], s[7 * 33]);
        *(v4u*)(WT + (size_t)(n0 + n) * K + k0 + 8 * c) = o; }
    asm volatile("s_waitcnt lgkmcnt(0)" ::: "memory");
}
DI const float* xrow_ptr(const Params& p, int m) { return m < MP ? p.in[I_XP] + (size_t)m * DM : p.in[I_XS] + (size_t)(m - MP) * DM; }
DI void rms_row_to_bf16(const float* xrow, const float* g, bf16* orow, int lane) {
    const f32x4* xr = (const f32x4*)xrow + lane; const f32x4* gr = (const f32x4*)g + lane;
    f32x4 v[4]; float s = 0.f;
#pragma unroll
    for (int j = 0; j < 4; ++j) { v[j] = xr[64 * j]; s += (v[j].x * v[j].x + v[j].y * v[j].y) + (v[j].z * v[j].z + v[j].w * v[j].w); }
    const float sc = 1.0f / sqrtf(wave_sum(s) * (1.f / DM) + EPS);
    unsigned long long* o8 = (unsigned long long*)orow + lane;
#pragma unroll
    for (int j = 0; j < 4; ++j) { const f32x4 gg = gr[64 * j]; o8[64 * j] = (unsigned long long)pk2(v[j].x * sc * gg.x, v[j].y * sc * gg.y) | ((unsigned long long)pk2(v[j].z * sc * gg.z, v[j].w * sc * gg.w) << 32); }
}
DI void p0_prologue(const Params& p, LAS unsigned char* lds, int gw, int NGW, int wave, int lane) {
    LAS float* scr = (LAS float*)(lds + wave * 16384);
    unsigned char* ws = p.ws;
    constexpr int I_IN = (DM / 64) * (DIN / 32), I_A = (512 / 64) * (DM / 32), I_O = (DM / 64) * (DM / 32), I_UP = (DM / 64) * (DFF / 32), I_DN = (DFF / 64) * (DM / 32), I_G = 16;
    constexpr int NITEMS = I_IN + 2 * I_A + I_O + I_UP + I_DN + 2 * I_G;
    for (int it = gw; it < NITEMS; it += NGW) {
        int r = it;
        if (r < I_IN) { p0_transpose_item(p.in[I_WIN], DM, DIN, (bf16*)(ws + WS_WIN), scr, r, lane); continue; } r -= I_IN;
        if (r < I_A) { p0_transpose_item(p.in[I_WA], 512, DM, (bf16*)(ws + WS_WA), scr, r, lane); continue; } r -= I_A;
        if (r < I_A) { p0_transpose_item(p.in[I_WB], 512, DM, (bf16*)(ws + WS_WB), scr, r, lane); continue; } r -= I_A;
        if (r < I_O) { p0_transpose_item(p.in[I_WO], DM, DM, (bf16*)(ws + WS_WO), scr, r, lane); continue; } r -= I_O;
        if (r < I_UP) { p0_transpose_item(p.in[I_WUP], DM, DFF, (bf16*)(ws + WS_WUP), scr, r, lane); continue; } r -= I_UP;
        if (r < I_DN) { p0_transpose_item(p.in[I_WDN], DFF, DM, (bf16*)(ws + WS_WDN), scr, r, lane); continue; } r -= I_DN;
        if (r < I_G) { p0_transpose_item(p.in[I_WR] + (r >> 1) * 4096, 64, 64, (bf16*)(ws + WS_WR) + (r >> 1) * 4096, scr, r & 1, lane); continue; } r -= I_G;
        p0_transpose_item(p.in[I_WI] + (r >> 1) * 4096, 64, 64, (bf16*)(ws + WS_WI) + (r >> 1) * 4096, scr, r & 1, lane);
    }
    bf16* XN = (bf16*)(ws + WS_XN);
    for (int m = gw; m < M; m += NGW) rms_row_to_bf16(xrow_ptr(p, m), p.in[I_GPM], XN + (size_t)m * DM, lane);
}

DI void attn_tile(const Params& p, int tile, int lane) {
    const bf16* PROJ = (const bf16*)(p.ws + WS_PROJ); bf16* OH = (bf16*)(p.ws + WS_XN);
    const int r = lane & 31, hh = lane >> 5;
    const bool samp = tile >= 4096;
    int b, h, pos0; size_t qrow0;
    if (!samp) { const int bh = tile >> 8; b = bh >> 3; h = bh & 7; pos0 = (tile & 255) * 32; qrow0 = (size_t)b * SEQ + pos0; }
    else { const int s = tile - 4096, bh = s >> 1; b = bh >> 3; h = bh & 7; pos0 = PAST + 32 * (s & 1); qrow0 = (size_t)MP + b * DSEQ + (pos0 - PAST); }
    const size_t krow0 = qrow0 - pos0;
    bf16x8 qf[4];
#pragma unroll
    for (int s = 0; s < 4; ++s) qf[s] = *(const bf16x8*)(PROJ + (qrow0 + r) * pg8::PROJ_LD + C_Q + h * 64 + 16 * s + 8 * hh);
    f32x16 o0, o1;
#pragma unroll
    for (int i = 0; i < 16; ++i) { o0[i] = 0.f; o1[i] = 0.f; }
    float R = 0.f;
    const int kb_hi = pos0 >> 5;
    for (int kb = kb_hi; kb >= 0; --kb) {
        const int p0 = kb * 32;
        bf16x8 kf[4], vf[2][2];
        if (!samp || p0 >= PAST) {
            const bf16* kr = PROJ + (krow0 + p0 + r) * pg8::PROJ_LD + C_K + h * 64 + 8 * hh;
#pragma unroll
            for (int s = 0; s < 4; ++s) kf[s] = *(const bf16x8*)(kr + 16 * s);
            const bf16* vb = PROJ + (krow0 + p0) * pg8::PROJ_LD + C_V + h * 64 + r;
#pragma unroll
            for (int s = 0; s < 2; ++s)
#pragma unroll
                for (int j = 0; j < 8; ++j) { const int key = 16 * s + 8 * (j >> 2) + 4 * hh + (j & 3); const bf16* vp = vb + (size_t)key * pg8::PROJ_LD;
                    vf[s][0][j] = (short)vp[0]; vf[s][1][j] = (short)vp[32]; }
        } else {
            const float* kr = p.in[I_CK] + ((size_t)(b * PAST + p0 + r) * 8 + h) * 64 + 8 * hh;
#pragma unroll
            for (int s = 0; s < 4; ++s) { const f32x4 a = *(const f32x4*)(kr + 16 * s), c = *(const f32x4*)(kr + 16 * s + 4);
                v4u w; w.x = pk2(a.x, a.y); w.y = pk2(a.z, a.w); w.z = pk2(c.x, c.y); w.w = pk2(c.z, c.w); kf[s] = __builtin_bit_cast(bf16x8, w); }
            const float* vb = p.in[I_CV] + ((size_t)(b * PAST + p0) * 8 + h) * 64 + r;
#pragma unroll
            for (int s = 0; s < 2; ++s) { float t0[8], t1[8];
#pragma unroll
                for (int j = 0; j < 8; ++j) { const int key = 16 * s + 8 * (j >> 2) + 4 * hh + (j & 3); const float* vp = vb + (size_t)key * 512; t0[j] = vp[0]; t1[j] = vp[32]; }
                v4u w0, w1; w0.x = pk2(t0[0], t0[1]); w0.y = pk2(t0[2], t0[3]); w0.z = pk2(t0[4], t0[5]); w0.w = pk2(t0[6], t0[7]);
                w1.x = pk2(t1[0], t1[1]); w1.y = pk2(t1[2], t1[3]); w1.z = pk2(t1[4], t1[5]); w1.w = pk2(t1[6], t1[7]);
                vf[s][0] = __builtin_bit_cast(bf16x8, w0); vf[s][1] = __builtin_bit_cast(bf16x8, w1); }
        }
        f32x16 st;
#pragma unroll
        for (int i = 0; i < 16; ++i) st[i] = 0.f;
#pragma unroll
        for (int s = 0; s < 4; ++s) st = MFMA32(kf[s], qf[s], st);
        const bool diag = (kb == kb_hi);
        float z[16], L[16];
#pragma unroll
        for (int i = 0; i < 16; ++i) { z[i] = st[i] * 0.125f;
            const float e = __builtin_amdgcn_exp2f(-fabsf(z[i]) * LOG2E);
            const float sp = fmaxf(z[i], 0.f) + LN2 * __builtin_amdgcn_logf(1.0f + e);
            const bool valid = !diag || (crow(i, hh) < r);
            L[i] = valid ? -sp : 0.f; }
        float Te[4], To[4];
#pragma unroll
        for (int g = 0; g < 4; ++g) { const float T = (L[4 * g] + L[4 * g + 1]) + (L[4 * g + 2] + L[4 * g + 3]); swap32(T, Te[g], To[g]); }
        float So[4], Sv[4]; So[3] = 0.f; Sv[3] = To[3]; So[2] = Sv[3] + Te[3]; Sv[2] = So[2] + To[2]; So[1] = Sv[2] + Te[2]; Sv[1] = So[1] + To[1]; So[0] = Sv[1] + Te[1]; Sv[0] = So[0] + To[0];
        const float total = Sv[0] + Te[0];
        float w[16];
#pragma unroll
        for (int g = 0; g < 4; ++g) { float run = R + (So[g] + (hh ? 0.f : To[g]));
#pragma unroll
            for (int q = 3; q >= 0; --q) { const int i = 4 * g + q; run += L[i];
                const bool valid = !diag || (crow(i, hh) < r);
                w[i] = valid ? __builtin_amdgcn_exp2f((z[i] + run) * LOG2E) : 0.f; } }
        R += total;
#pragma unroll
        for (int s = 0; s < 2; ++s) { v4u x; x.x = pk2(w[8 * s], w[8 * s + 1]); x.y = pk2(w[8 * s + 2], w[8 * s + 3]); x.z = pk2(w[8 * s + 4], w[8 * s + 5]); x.w = pk2(w[8 * s + 6], w[8 * s + 7]);
            const bf16x8 xs = __builtin_bit_cast(bf16x8, x);
            o0 = MFMA32(xs, vf[s][0], o0); o1 = MFMA32(xs, vf[s][1], o1); }
        if (__all(R < -110.f)) break;
    }
    bf16* ob = OH + qrow0 * DM + h * 64 + r;
#pragma unroll
    for (int i = 0; i < 16; ++i) { bf16* op = ob + (size_t)crow(i, hh) * DM; op[0] = (bf16)(pk2(o0[i], 0.f) & 0xffffu); op[32] = (bf16)(pk2(o1[i], 0.f) & 0xffffu); }
}

template <int PASS> DI void scan_unit(const Params& p, int unit, LAS float* scr, int lane) {
    const bf16* PROJ = (const bf16*)(p.ws + WS_PROJ); bf16* OH = (bf16*)(p.ws + WS_XN);
    float* AGA = (float*)(p.ws + WS_AGA); float* AGB = (float*)(p.ws + WS_AGB);
    const int r = lane & 31, hh = lane >> 5;
    const bool samp = unit >= 2048;
    int b, c, n; size_t row0;
    if (!samp) { b = unit >> 10; c = (unit >> 3) & 127; n = unit & 7; row0 = (size_t)b * SEQ + c * 64; }
    else { const int s = unit - 2048; b = s >> 3; c = 0; n = s & 7; row0 = (size_t)MP + b * DSEQ; }
    const int ch0 = n * 64;
#pragma unroll 1
    for (int it = 0; it < 8; ++it) { const int t = 32 * (it >> 2) + r, c0 = 16 * (it & 3) + 8 * hh;
        float a8[8];
        { const f32x4 b0 = *(const f32x4*)(p.in[I_BC] + ch0 + c0), b1 = *(const f32x4*)(p.in[I_BC] + ch0 + c0 + 4);
          a8[0] = b0.x; a8[1] = b0.y; a8[2] = b0.z; a8[3] = b0.w; a8[4] = b1.x; a8[5] = b1.y; a8[6] = b1.z; a8[7] = b1.w; }
#pragma unroll
        for (int j = 0; j < 4; ++j) { const int tt = t - 3 + j; float x8[8];
            if (tt >= 0 || c > 0) { const v4u xv = *(const v4u*)(PROJ + (row0 + tt) * pg8::PROJ_LD + C_U + ch0 + c0);
                x8[0] = blo(xv.x); x8[1] = bhi(xv.x); x8[2] = blo(xv.y); x8[3] = bhi(xv.y); x8[4] = blo(xv.z); x8[5] = bhi(xv.z); x8[6] = blo(xv.w); x8[7] = bhi(xv.w); }
            else if (samp) { const float* sp = p.in[I_SC] + (size_t)(b * 3 + 3 + tt) * 512 + ch0 + c0; const f32x4 s0 = *(const f32x4*)sp, s1 = *(const f32x4*)(sp + 4);
                x8[0] = s0.x; x8[1] = s0.y; x8[2] = s0.z; x8[3] = s0.w; x8[4] = s1.x; x8[5] = s1.y; x8[6] = s1.z; x8[7] = s1.w; }
            else {
#pragma unroll
                for (int k = 0; k < 8; ++k) x8[k] = 0.f; }
            const float* wp = p.in[I_WC] + j * 512 + ch0 + c0; const f32x4 w0 = *(const f32x4*)wp, w1 = *(const f32x4*)(wp + 4);
            a8[0] += x8[0] * w0.x; a8[1] += x8[1] * w0.y; a8[2] += x8[2] * w0.z; a8[3] += x8[3] * w0.w; a8[4] += x8[4] * w1.x; a8[5] += x8[5] * w1.y; a8[6] += x8[6] * w1.z; a8[7] += x8[7] * w1.w; }
        const int q0 = c0 >> 2, sw = t & 15;
        *(LAS f32x4*)(scr + t * 64 + ((q0 ^ sw) << 2)) = (f32x4){a8[0], a8[1], a8[2], a8[3]};
        *(LAS f32x4*)(scr + t * 64 + (((q0 + 1) ^ sw) << 2)) = (f32x4){a8[4], a8[5], a8[6], a8[7]}; }
    float hc = 0.f;
    if (PASS == 2) {
        if (samp) hc = p.in[I_SH][b * 512 + ch0 + lane];
        else { const float* pa = AGA + (size_t)b * 128 * 512 + ch0 + lane; const float* pb = AGB + (size_t)b * 128 * 512 + ch0 + lane;
            for (int cc = 0; cc < c; ++cc) hc = pa[(size_t)cc * 512] * hc + pb[(size_t)cc * 512]; }
    }
    const bf16* WRT = (const bf16*)(p.ws + WS_WR) + n * 4096; const bf16* WIT = (const bf16*)(p.ws + WS_WI) + n * 4096;
#pragma unroll 1
    for (int db = 0; db < 2; ++db) { const int d = 32 * db + r;
        bf16x8 wr[4], wi[4];
#pragma unroll
        for (int s = 0; s < 4; ++s) { wr[s] = *(const bf16x8*)(WRT + d * 64 + 16 * s + 8 * hh); wi[s] = *(const bf16x8*)(WIT + d * 64 + 16 * s + 8 * hh); }
        const float br = p.in[I_BR][ch0 + d], bi = p.in[I_BI][ch0 + d], lam = p.in[I_LAM][ch0 + d];
        const float cl = -8.0f * (fmaxf(-lam, 0.f) + log1pf(expf(-fabsf(lam))));
        float car = (PASS == 2) ? __shfl(hc, d) : 0.f, agA = 1.f, agB = 0.f;
#pragma unroll 1
        for (int tb = 0; tb < 2; ++tb) {
            f32x16 aR, aI;
#pragma unroll
            for (int i = 0; i < 16; ++i) { aR[i] = 0.f; aI[i] = 0.f; }
            { const int t = 32 * tb + r, sw = t & 15;
#pragma unroll
              for (int s = 0; s < 4; ++s) { const int q0 = (16 * s + 8 * hh) >> 2;
                const f32x4 x0 = *(const LAS f32x4*)(scr + t * 64 + ((q0 ^ sw) << 2)), x1 = *(const LAS f32x4*)(scr + t * 64 + (((q0 + 1) ^ sw) << 2));
                v4u w; w.x = pk2(x0.x, x0.y); w.y = pk2(x0.z, x0.w); w.z = pk2(x1.x, x1.y); w.w = pk2(x1.z, x1.w); const bf16x8 af = __builtin_bit_cast(bf16x8, w);
                aR = MFMA32(af, wr[s], aR); aI = MFMA32(af, wi[s], aI); } }
            float av[16], uv[16];
#pragma unroll
            for (int i = 0; i < 16; ++i) { const int t = 32 * tb + crow(i, hh);
                const float rg = sigm(aR[i] + br), ig = sigm(aI[i] + bi);
                const float la = cl * rg;
                av[i] = __builtin_amdgcn_exp2f(la * LOG2E);
                const float ucv = scr[t * 64 + (((d >> 2) ^ (t & 15)) << 2) + (d & 3)];
                uv[i] = sqrtf(-expm1f(2.0f * la)) * (ig * ucv); }
#pragma unroll
            for (int g = 0; g < 4; ++g) {
                float Ag = 1.f, Bg = 0.f;
#pragma unroll
                for (int q = 0; q < 4; ++q) { Bg = av[4 * g + q] * Bg + uv[4 * g + q]; Ag *= av[4 * g + q]; }
                float Al, Ah, Bl, Bh; swap32(Ag, Al, Ah); swap32(Bg, Bl, Bh);
                if (PASS == 1) { agB = Al * agB + Bl; agA *= Al; agB = Ah * agB + Bh; agA *= Ah; }
                else { const float hs_hi = Al * car + Bl; float hv = hh ? hs_hi : car;
#pragma unroll
                    for (int q = 0; q < 4; ++q) { const int i = 4 * g + q; const int t = 32 * tb + crow(i, hh);
                        hv = av[i] * hv + uv[i];
                        const float gr = bf2f(PROJ[(row0 + t) * pg8::PROJ_LD + C_GR + ch0 + d]);
                        const float ge = gr * sigm(1.5957691216057308f * (gr + 0.044715f * gr * gr * gr));
                        OH[(row0 + t) * DM + 512 + ch0 + d] = (bf16)(pk2(hv * ge, 0.f) & 0xffffu); }
                    car = Ah * hs_hi + Bh; }
            }
        }
        if (PASS == 1) { if (hh == 0) { AGA[((size_t)b * 128 + c) * 512 + ch0 + d] = agA; AGB[((size_t)b * 128 + c) * 512 + ch0 + d] = agB; } }
        else if (hh == 0 && (samp || c == 127)) { p.out[(samp ? pg8::OFF_HS : pg8::OFF_HP) + (size_t)b * 512 + ch0 + d] = car; }
    }
    if (PASS == 2 && (samp || c == 127)) {
#pragma unroll
        for (int j = 0; j < 3; ++j) p.out[(samp ? pg8::OFF_CS : pg8::OFF_CP) + (size_t)(b * 3 + j) * 512 + ch0 + lane] = bf2f(PROJ[(row0 + 61 + j) * pg8::PROJ_LD + C_U + ch0 + lane]);
    }
}

DI void norm_a_row(const Params& p, int m, int lane) {
    const f32x4* xr = (const f32x4*)xrow_ptr(p, m) + lane; const f32x4* mr = (const f32x4*)((const float*)(p.ws + WS_PROJ) + (size_t)m * DM) + lane;
    const f32x4* g1 = (const f32x4*)p.in[I_GPOM] + lane; const f32x4* g2 = (const f32x4*)p.in[I_GPF] + lane;
    f32x4 v[4], x1[4]; float s = 0.f;
#pragma unroll
    for (int j = 0; j < 4; ++j) { v[j] = mr[64 * j]; s += (v[j].x * v[j].x + v[j].y * v[j].y) + (v[j].z * v[j].z + v[j].w * v[j].w); }
    const float sc = 1.0f / sqrtf(wave_sum(s) * (1.f / DM) + EPS); float s2 = 0.f;
    f32x4* yo = (f32x4*)(p.out + pg8::OFF_Y + (size_t)m * DM) + lane;
#pragma unroll
    for (int j = 0; j < 4; ++j) { x1[j] = xr[64 * j] + v[j] * sc * g1[64 * j]; yo[64 * j] = x1[j]; s2 += (x1[j].x * x1[j].x + x1[j].y * x1[j].y) + (x1[j].z * x1[j].z + x1[j].w * x1[j].w); }
    const float sc2 = 1.0f / sqrtf(wave_sum(s2) * (1.f / DM) + EPS);
    unsigned long long* o8 = (unsigned long long*)((bf16*)(p.ws + WS_XN) + (size_t)m * DM) + lane;
#pragma unroll
    for (int j = 0; j < 4; ++j) { const f32x4 gg = g2[64 * j]; o8[64 * j] = (unsigned long long)pk2(x1[j].x * sc2 * gg.x, x1[j].y * sc2 * gg.y) | ((unsigned long long)pk2(x1[j].z * sc2 * gg.z, x1[j].w * sc2 * gg.w) << 32); }
}
DI void norm_b_row(const Params& p, int m, int lane) {
    const f32x4* dr = (const f32x4*)((const float*)(p.ws + WS_DOWN) + (size_t)m * DM) + lane; const f32x4* g = (const f32x4*)p.in[I_GPOF] + lane;
    f32x4* yo = (f32x4*)(p.out + pg8::OFF_Y + (size_t)m * DM) + lane;
    f32x4 v[4]; float s = 0.f;
#pragma unroll
    for (int j = 0; j < 4; ++j) { v[j] = dr[64 * j]; s += (v[j].x * v[j].x + v[j].y * v[j].y) + (v[j].z * v[j].z + v[j].w * v[j].w); }
    const float sc = 1.0f / sqrtf(wave_sum(s) * (1.f / DM) + EPS);
#pragma unroll
    for (int j = 0; j < 4; ++j) yo[64 * j] = yo[64 * j] + v[j] * sc * g[64 * j];
}

__global__ void __launch_bounds__(NWAVES * 64, 2) fwd_mega(Params p) {
    extern __shared__ __attribute__((aligned(16))) unsigned char lds_raw[];
    cg::grid_group grid = cg::this_grid();
    LAS unsigned char* lds = (LAS unsigned char*)lds_raw;
    const int tid = threadIdx.x, lane = tid & 63, wave = __builtin_amdgcn_readfirstlane(tid >> 6);
    const int G = gridDim.x, bx = blockIdx.x;
    const int vcu = (G % 8 == 0) ? (bx % 8) * (G / 8) + bx / 8 : bx;
    const int gw = vcu * NWAVES + wave, NGW = G * NWAVES;
    unsigned char* ws = p.ws;
    pg8::bf16_t* PROJ = (pg8::bf16_t*)(ws + WS_PROJ); pg8::bf16_t* XN = (pg8::bf16_t*)(ws + WS_XN); pg8::bf16_t* YA = (pg8::bf16_t*)(ws + WS_YA);

    p0_prologue(p, lds, gw, NGW, wave, lane);
    grid.sync();
    { pg8::Gemm g{XN, (const pg8::bf16_t*)(ws + WS_WIN), M, DIN, DM, DM}; pg8::StaticOrder S; S.init(M, DIN, G, bx);
      pg8::EpiProj E{PROJ, p.out};
      pg8::gemm_phase<pg8::EpiProj, pg8::StaticOrder, true, true>(lds, g, S, E); }
    grid.sync();
    { LAS float* scr = (LAS float*)(lds + wave * 16384);
      for (int u = gw; u < 2048; u += NGW) scan_unit<1>(p, u, scr, lane); }
    grid.sync();
    { LAS float* scr = (LAS float*)(lds + wave * 16384);
      for (int u = gw; u < 2176; u += NGW) scan_unit<2>(p, u, scr, lane);
      for (int t = gw; t < 4352; t += NGW) attn_tile(p, t, lane); }
    grid.sync();
    { pg8::Gemm g{XN, (const pg8::bf16_t*)(ws + WS_WA), M, DM, 512, DM}; pg8::StaticOrder S; S.init(M, DM, G, bx);
      pg8::EpiGate<0> E{YA, PROJ};
      pg8::gemm_phase<pg8::EpiGate<0>, pg8::StaticOrder, true, true>(lds, g, S, E); }
    grid.sync();
    { pg8::Gemm g{XN + 512, (const pg8::bf16_t*)(ws + WS_WB), M, DM, 512, DM}; pg8::StaticOrder S; S.init(M, DM, G, bx);
      pg8::EpiGate<1> E{YA, PROJ};
      pg8::gemm_phase<pg8::EpiGate<1>, pg8::StaticOrder, true, true>(lds, g, S, E); }
    grid.sync();
    { pg8::Gemm g{YA, (const pg8::bf16_t*)(ws + WS_WO), M, DM, DM, DM}; pg8::StaticOrder S; S.init(M, DM, G, bx);
      pg8::EpiF32 E{(float*)(ws + WS_PROJ), DM};
      pg8::gemm_phase<pg8::EpiF32, pg8::StaticOrder, true, true>(lds, g, S, E); }
    grid.sync();
    for (int m = gw; m < M; m += NGW) norm_a_row(p, m, lane);
    grid.sync();
    { pg8::Gemm g{XN, (const pg8::bf16_t*)(ws + WS_WUP), M, DFF, DM, DM}; pg8::StaticOrder S; S.init(M, DFF, G, bx);
      pg8::EpiRelu2 E{PROJ, DFF};
      pg8::gemm_phase<pg8::EpiRelu2, pg8::StaticOrder, true, true>(lds, g, S, E); }
    grid.sync();
    { pg8::Gemm g{PROJ, (const pg8::bf16_t*)(ws + WS_WDN), M, DM, DFF, DFF}; pg8::StaticOrder S; S.init(M, DM, G, bx);
      pg8::EpiF32 E{(float*)(ws + WS_DOWN), DM};
      pg8::gemm_phase<pg8::EpiF32, pg8::StaticOrder, true, true>(lds, g, S, E); }
    grid.sync();
    for (int m = gw; m < M; m += NGW) norm_b_row(p, m, lane);
}

extern "C" void kernel_launch(void* const* d_in, const int* in_sizes, int n_in, void* d_out, int out_size, void* d_ws, size_t ws_size, hipStream_t stream) {
    static int grid = 0;
    if (grid == 0) {
        if (n_in != 23 || in_sizes[0] != MP * DM || (size_t)out_size != pg8::OUT_TOTAL || ws_size < WS_END) { fprintf(stderr, "kernel_launch: unexpected shapes (n_in %d, in0 %d, out %d, ws %zu)\n", n_in, n_in > 0 ? in_sizes[0] : -1, out_size, ws_size); grid = -1; return; }
        int dev = 0, cus = 0, per_cu = 0;
        if (hipGetDevice(&dev) != hipSuccess || hipDeviceGetAttribute(&cus, hipDeviceAttributeMultiprocessorCount, dev) != hipSuccess) { grid = -1; return; }
        if (hipFuncSetAttribute((const void*)fwd_mega, hipFuncAttributeMaxDynamicSharedMemorySize, LDS_BYTES) != hipSuccess) { fprintf(stderr, "kernel_launch: hipFuncSetAttribute failed\n"); grid = -1; return; }
        if (hipOccupancyMaxActiveBlocksPerMultiprocessor(&per_cu, (const void*)fwd_mega, NWAVES * 64, LDS_BYTES) != hipSuccess || per_cu < 1) { fprintf(stderr, "kernel_launch: occupancy query says %d blocks per CU\n", per_cu); per_cu = 1; }
        (void)hipGetLastError();
        grid = cus;
    }
    if (grid < 0) return;
    Params prm{};
    for (int i = 0; i < 23; ++i) prm.in[i] = (const float*)d_in[i];
    prm.out = (float*)d_out; prm.ws = (unsigned char*)d_ws;
    void* args[] = {&prm};
    hipError_t e = hipLaunchCooperativeKernel((const void*)fwd_mega, dim3(grid), dim3(NWAVES * 64), args, LDS_BYTES, stream);
    if (e != hipSuccess) fprintf(stderr, "kernel_launch: cooperative launch failed: %s (grid %d)\n", hipGetErrorString(e), grid);
}
```

```cpp
#include <hip/hip_runtime.h>
#include <hip/hip_cooperative_groups.h>
#include <cstdio>
#include <cstdint>
namespace cg = cooperative_groups;
namespace pg8 {
#define PG8_LAS __attribute__((address_space(3)))
typedef unsigned short bf16_t;
typedef short bf16x8 __attribute__((ext_vector_type(8)));
typedef float f32x4 __attribute__((ext_vector_type(4)));
typedef unsigned u32x4 __attribute__((ext_vector_type(4)));
constexpr int BM = 256, BK = 64, HALF = 128, HTB = HALF * BK * 2  , STAGE_BYTES = 8 * HTB, NXCD = 8, WGM = 8;

__host__ __device__ __forceinline__ int lds_byte(int r, int c) { const int st = (r >> 4) * 2 + (c >> 5), rr = r & 15, cc = c & 31, ob = rr * 64 + cc * 2; return st * 1024 + (ob ^ (((ob >> 9) & 1) << 5)); }
__host__ __device__ __forceinline__ void stage_rc(int b, int& R, int& C) { const int st = b / 1024, sb = b % 1024, swz = sb ^ (((sb >> 9) & 1) << 5); R = (st >> 1) * 16 + swz / 64; C = (st & 1) * 32 + (swz % 64) / 2; }
__host__ __device__ __forceinline__ int perm32(int rho) { const int n = rho >> 4, i = rho & 15; return 8 * (i >> 2) + 4 * n + (i & 3); }

struct Unit { int pm, pn; };
struct Gemm { const bf16_t* A; const bf16_t* Bt; int M, N, K, lda; };

struct StaticOrder {
    int nM, nN, nwg, G, c;
    __host__ __device__ void init(int M, int N, int G_, int c_) { nM = M / BM; nN = N / BM; nwg = nM * nN; G = G_; c = c_; }
    __host__ __device__ bool next(int i, Unit& u) const {
        const long L = (long)i * G + c; if (L >= nwg) return false;
        int wgid = (int)L; { const int q = nwg / NXCD, r = nwg % NXCD, xcd = wgid % NXCD, off = wgid / NXCD; wgid = (xcd < r ? xcd * (q + 1) : r * (q + 1) + (xcd - r) * q) + off; }
        const int nig = WGM * nN, gid = wgid / nig, fm = gid * WGM, gsz = (nM - fm) < WGM ? (nM - fm) : WGM;
        u.pm = fm + ((wgid % nig) % gsz); u.pn = (wgid % nig) / gsz; return true;
    }
    __device__ __forceinline__ void a_ready(const Unit&) const {}
    __device__ __forceinline__ void done(const Unit&) const {}
};

__device__ __forceinline__ unsigned cvt_pk_bf16(float lo, float hi) { unsigned r; asm volatile("v_cvt_pk_bf16_f32 %0, %1, %2" : "=v"(r) : "v"(lo), "v"(hi)); return r; }
__device__ __forceinline__ float bf_lo(unsigned w) { return __uint_as_float(w << 16); }
__device__ __forceinline__ float bf_hi(unsigned w) { return __uint_as_float(w & 0xffff0000u); }
__device__ __forceinline__ float sigmoidf_(float x) { return __builtin_amdgcn_rcpf(1.0f + __builtin_amdgcn_exp2f(-1.4426950408889634f * x)); }
constexpr int PROJ_LD = 4608;
constexpr size_t OFF_Y = 0, OFF_KP = 17825792, OFF_VP = 26214400, OFF_CP = 34603008, OFF_HP = 34606080, OFF_KS = 34607104, OFF_VS = 35131392, OFF_CS = 35655680, OFF_HS = 35680256, OUT_TOTAL = 35688448;

struct EpiProj {
    static constexpr bool PERM = true, AFTER_DRAIN = false;
    bf16_t* P; float* out;
    __device__ __forceinline__ void operator()(const f32x4 (&acc)[2][2][4][2], const Unit& u, int wr, int wc, int fr, int fq) const {
        const int row0 = u.pm * BM + wr * 64 + fr, col0 = u.pn * BM + wc * 32 + 8 * fq;
        const bool iskv = (u.pn >= 2 && u.pn < 6), isv = u.pn >= 4, samp = u.pm >= 64;
        float* kvb = out + (samp ? (isv ? OFF_VS : OFF_KS) : (isv ? OFF_VP : OFF_KP)) - (samp ? (size_t)16384 * 512 : 0) + (col0 - (isv ? 1024 : 512));
#pragma unroll
        for (int ai = 0; ai < 2; ++ai)
#pragma unroll
            for (int m = 0; m < 4; ++m) { const int row = row0 + ai * HALF + m * 16; bf16_t* rowp = P + (size_t)row * PROJ_LD + col0;
#pragma unroll
                for (int bj = 0; bj < 2; ++bj) { const f32x4 v0 = acc[ai][bj][m][0], v1 = acc[ai][bj][m][1];
                    u32x4 w; w.x = cvt_pk_bf16(v0[0], v0[1]); w.y = cvt_pk_bf16(v0[2], v0[3]); w.z = cvt_pk_bf16(v1[0], v1[1]); w.w = cvt_pk_bf16(v1[2], v1[3]);
                    *(u32x4*)(rowp + bj * HALF) = w;
                    if (iskv) { float* d = kvb + (size_t)row * 512 + bj * HALF; *(f32x4*)d = v0; *(f32x4*)(d + 4) = v1; } } }
    }
};
template <int MODE  > struct EpiGate {
    static constexpr bool PERM = true, AFTER_DRAIN = false;
    bf16_t* Y; const bf16_t* P;
    __device__ __forceinline__ void operator()(const f32x4 (&acc)[2][2][4][2], const Unit& u, int wr, int wc, int fr, int fq) const {
        const int row0 = u.pm * BM + wr * 64 + fr, col0 = u.pn * BM + wc * 32 + 8 * fq;
#pragma unroll
        for (int ai = 0; ai < 2; ++ai)
#pragma unroll
            for (int m = 0; m < 4; ++m) { const int row = row0 + ai * HALF + m * 16; bf16_t* rowp = Y + (size_t)row * 1024 + col0; const bf16_t* gp = P + (size_t)row * PROJ_LD + (MODE == 0 ? 2560 : 3584) + col0;
#pragma unroll
                for (int bj = 0; bj < 2; ++bj) { const f32x4 v0 = acc[ai][bj][m][0], v1 = acc[ai][bj][m][1];
                    const u32x4 g = *(const u32x4*)(gp + bj * HALF);
                    float o[8] = { sigmoidf_(bf_lo(g.x)) * v0[0], sigmoidf_(bf_hi(g.x)) * v0[1], sigmoidf_(bf_lo(g.y)) * v0[2], sigmoidf_(bf_hi(g.y)) * v0[3],
                                   sigmoidf_(bf_lo(g.z)) * v1[0], sigmoidf_(bf_hi(g.z)) * v1[1], sigmoidf_(bf_lo(g.w)) * v1[2], sigmoidf_(bf_hi(g.w)) * v1[3] };
                    if (MODE == 1) { const u32x4 y = *(const u32x4*)(rowp + bj * HALF);
                        o[0] += bf_lo(y.x); o[1] += bf_hi(y.x); o[2] += bf_lo(y.y); o[3] += bf_hi(y.y); o[4] += bf_lo(y.z); o[5] += bf_hi(y.z); o[6] += bf_lo(y.w); o[7] += bf_hi(y.w); }
                    u32x4 w; w.x = cvt_pk_bf16(o[0], o[1]); w.y = cvt_pk_bf16(o[2], o[3]); w.z = cvt_pk_bf16(o[4], o[5]); w.w = cvt_pk_bf16(o[6], o[7]);
                    *(u32x4*)(rowp + bj * HALF) = w; } }
    }
};
struct EpiF32 {
    static constexpr bool PERM = true, AFTER_DRAIN = false;
    float* O; int ldc;
    __device__ __forceinline__ void operator()(const f32x4 (&acc)[2][2][4][2], const Unit& u, int wr, int wc, int fr, int fq) const {
        const int row0 = u.pm * BM + wr * 64 + fr, col0 = u.pn * BM + wc * 32 + 8 * fq;
#pragma unroll
        for (int ai = 0; ai < 2; ++ai)
#pragma unroll
            for (int m = 0; m < 4; ++m) { float* rowp = O + (size_t)(row0 + ai * HALF + m * 16) * ldc + col0;
#pragma unroll
                for (int bj = 0; bj < 2; ++bj) { *(f32x4*)(rowp + bj * HALF) = acc[ai][bj][m][0]; *(f32x4*)(rowp + bj * HALF + 4) = acc[ai][bj][m][1]; } }
    }
};
struct EpiRelu2 {
    static constexpr bool PERM = true, AFTER_DRAIN = false;
    bf16_t* O; int ldc;
    __device__ __forceinline__ void operator()(const f32x4 (&acc)[2][2][4][2], const Unit& u, int wr, int wc, int fr, int fq) const {
        const int row0 = u.pm * BM + wr * 64 + fr, col0 = u.pn * BM + wc * 32 + 8 * fq;
#pragma unroll
        for (int ai = 0; ai < 2; ++ai)
#pragma unroll
            for (int m = 0; m < 4; ++m) { bf16_t* rowp = O + (size_t)(row0 + ai * HALF + m * 16) * ldc + col0;
#pragma unroll
                for (int bj = 0; bj < 2; ++bj) { f32x4 v0 = acc[ai][bj][m][0], v1 = acc[ai][bj][m][1];
#pragma unroll
                    for (int e = 0; e < 4; ++e) { const float a = fmaxf(v0[e], 0.f), b = fmaxf(v1[e], 0.f); v0[e] = a * a; v1[e] = b * b; }
                    u32x4 w; w.x = cvt_pk_bf16(v0[0], v0[1]); w.y = cvt_pk_bf16(v0[2], v0[3]); w.z = cvt_pk_bf16(v1[0], v1[1]); w.w = cvt_pk_bf16(v1[2], v1[3]);
                    *(u32x4*)(rowp + bj * HALF) = w; } }
    }
};
template <class Epi, class Sched, bool ALIGN_EPI = false, bool SP2 = false>
__device__ __forceinline__ void gemm_phase(PG8_LAS unsigned char* lds, const Gemm g, const Sched& S, const Epi& E) {
    const int tid = threadIdx.x, wid = __builtin_amdgcn_readfirstlane(tid >> 6), lane = tid & 63, wr = wid >> 2, wc = wid & 3, fr = lane & 15, fq = lane >> 4;
    const int K = g.K, nt = K / BK;
    unsigned voffA[2], voffB[2];
#pragma unroll
    for (int i = 0; i < 2; ++i) { int R, C; stage_rc(tid * 16 + i * 8192, R, C); const int Rb = Epi::PERM ? ((R & ~31) + perm32(R & 31)) : R;
        voffA[i] = (unsigned)(R * g.lda + C) * 2u; voffB[i] = (unsigned)(Rb * K + C) * 2u; }
    const size_t kstep = (size_t)(BK * 2);
    const size_t hstepA = (size_t)HALF * g.lda * 2, hstepB = (size_t)HALF * K * 2;
    const size_t tstepA = 2 * hstepA, tstepB = 2 * hstepB;
    const unsigned ldsw = (unsigned)wid * 1024u;
    const int aoff = lds_byte(wr * 64 + fr, fq * 8), boff = lds_byte(wc * 32 + fr, fq * 8);
#define PG8_SA(b, h) (((b) * 2 + (h)) * HTB)
#define PG8_SB(b, h) ((4 + (b) * 2 + (h)) * HTB)
#define PG8_STAGE(bufoff, gbase, voff) do { _Pragma("unroll") for (int _i = 0; _i < 2; ++_i) \
        __builtin_amdgcn_global_load_lds((const unsigned*)((const char*)(gbase) + (voff)[_i]), (PG8_LAS unsigned*)(lds + (bufoff) + ldsw + _i * 8192), 16, 0, 0); } while (0)
#define PG8_LDA(dst, b, h) do { _Pragma("unroll") for (int m = 0; m < 4; ++m) _Pragma("unroll") for (int k = 0; k < 2; ++k) dst[m][k] = *(const PG8_LAS bf16x8*)(lds + PG8_SA(b, h) + aoff + m * 2048 + k * 1024); } while (0)
#define PG8_LDB(dst, b, h) do { _Pragma("unroll") for (int n = 0; n < 2; ++n) _Pragma("unroll") for (int k = 0; k < 2; ++k) dst[n][k] = *(const PG8_LAS bf16x8*)(lds + PG8_SB(b, h) + boff + n * 2048 + k * 1024); } while (0)
#define PG8_MMA(ai, bj, At, Bt) do { __builtin_amdgcn_s_setprio(1); _Pragma("unroll") for (int m = 0; m < 4; ++m) _Pragma("unroll") for (int n = 0; n < 2; ++n) _Pragma("unroll") for (int k = 0; k < 2; ++k) \
        acc[ai][bj][m][n] = __builtin_amdgcn_mfma_f32_16x16x32_bf16(Bt[n][k], At[m][k], acc[ai][bj][m][n], 0, 0, 0); __builtin_amdgcn_s_setprio(0); } while (0)
#define PG8_WAIT_V(n) asm volatile("s_waitcnt vmcnt(" #n ")" ::: "memory")
#define PG8_WAIT_L(n) asm volatile("s_waitcnt lgkmcnt(" #n ")" ::: "memory")
#define PG8_BAR __builtin_amdgcn_s_barrier()
#define PG8_SCHED __builtin_amdgcn_sched_barrier(0)
    Unit cur, nxt; int ui = 0;
    if (!S.next(0, cur)) return;
    f32x4 acc[2][2][4][2];
#pragma unroll
    for (int a = 0; a < 2; ++a)
#pragma unroll
        for (int b = 0; b < 2; ++b)
#pragma unroll
            for (int m = 0; m < 4; ++m)
#pragma unroll
                for (int n = 0; n < 2; ++n) acc[a][b][m][n] = (f32x4){0.f, 0.f, 0.f, 0.f};
    bf16x8 At[4][2], B0[2][2], B1[2][2];
    const char* cA = (const char*)g.A + (size_t)cur.pm * tstepA; const char* cB = (const char*)g.Bt + (size_t)cur.pn * tstepB;
    S.a_ready(cur);
    if constexpr (SP2) {
        PG8_STAGE(PG8_SB(0, 0), cB, voffB); PG8_STAGE(PG8_SB(0, 1), cB + hstepB, voffB); PG8_STAGE(PG8_SA(0, 0), cA, voffA); PG8_STAGE(PG8_SA(0, 1), cA + hstepA, voffA);
        if (wr == 1) PG8_BAR;
        PG8_WAIT_V(2); PG8_BAR;
        PG8_STAGE(PG8_SB(1, 0), cB + kstep, voffB); PG8_STAGE(PG8_SA(1, 0), cA + kstep, voffA); PG8_STAGE(PG8_SB(1, 1), cB + hstepB + kstep, voffB);
        PG8_WAIT_V(6); PG8_BAR;
    } else {
        PG8_STAGE(PG8_SB(0, 0), cB, voffB); PG8_STAGE(PG8_SA(0, 0), cA, voffA); PG8_STAGE(PG8_SB(0, 1), cB + hstepB, voffB); PG8_STAGE(PG8_SA(0, 1), cA + hstepA, voffA);
        if (wr == 1) PG8_BAR;
        PG8_WAIT_V(4); PG8_BAR;
        PG8_STAGE(PG8_SB(1, 0), cB + kstep, voffB); PG8_STAGE(PG8_SA(1, 0), cA + kstep, voffA); PG8_STAGE(PG8_SB(1, 1), cB + hstepB + kstep, voffB);
        PG8_WAIT_V(6); PG8_BAR;
    }
    for (;;) {
        const bool has_next = S.next(ui + 1, nxt);
        const char* nA = has_next ? (const char*)g.A + (size_t)nxt.pm * tstepA : cA; const char* nB = has_next ? (const char*)g.Bt + (size_t)nxt.pn * tstepB : cB;
        for (int t = 0; t < nt; t += 2) {
            const bool last = (t == nt - 2);
            const char* a1 = cA + (size_t)(t + 1) * kstep;
            const char* a2 = last ? nA : cA + (size_t)(t + 2) * kstep; const char* b2 = last ? nB : cB + (size_t)(t + 2) * kstep;
            const char* a3 = a2 + kstep; const char* b3 = b2 + kstep;
            if (last && has_next) S.a_ready(nxt);
            if constexpr (SP2) {
            PG8_LDB(B0, 0, 0); PG8_LDB(B1, 0, 1); PG8_SCHED; PG8_LDA(At, 0, 0); PG8_STAGE(PG8_SA(1, 1), a1 + hstepA, voffA);
            PG8_WAIT_V(8); PG8_WAIT_L(0); PG8_BAR; PG8_MMA(0, 0, At, B0); PG8_MMA(0, 1, At, B1); PG8_BAR; PG8_SCHED;
            PG8_LDA(At, 0, 1); PG8_STAGE(PG8_SB(0, 0), b2, voffB); PG8_STAGE(PG8_SB(0, 1), b2 + hstepB, voffB); PG8_STAGE(PG8_SA(0, 0), a2, voffA);
            PG8_WAIT_V(8); PG8_WAIT_L(0); PG8_BAR; PG8_MMA(1, 0, At, B0); PG8_MMA(1, 1, At, B1); PG8_BAR; PG8_SCHED;
            PG8_LDB(B0, 1, 0); PG8_LDB(B1, 1, 1); PG8_SCHED; PG8_LDA(At, 1, 0); PG8_STAGE(PG8_SA(0, 1), a2 + hstepA, voffA);
            PG8_WAIT_V(8); PG8_WAIT_L(0); PG8_BAR; PG8_MMA(0, 0, At, B0); PG8_MMA(0, 1, At, B1); PG8_BAR; PG8_SCHED;
            PG8_LDA(At, 1, 1); PG8_STAGE(PG8_SB(1, 0), b3, voffB); PG8_STAGE(PG8_SB(1, 1), b3 + hstepB, voffB); PG8_STAGE(PG8_SA(1, 0), a3, voffA);
            PG8_WAIT_V(8); PG8_WAIT_L(0); PG8_BAR; PG8_MMA(1, 0, At, B0); PG8_MMA(1, 1, At, B1); PG8_BAR; PG8_SCHED;
            } else {
            PG8_LDB(B0, 0, 0); PG8_SCHED; PG8_LDA(At, 0, 0); PG8_STAGE(PG8_SA(1, 1), a1 + hstepA, voffA);
            PG8_WAIT_L(8); PG8_BAR; PG8_WAIT_L(0); PG8_MMA(0, 0, At, B0); PG8_BAR; PG8_SCHED;
            PG8_LDB(B1, 0, 1); PG8_STAGE(PG8_SB(0, 0), b2, voffB);
            PG8_BAR; PG8_WAIT_L(0); PG8_MMA(0, 1, At, B1); PG8_BAR;
            PG8_LDA(At, 0, 1); PG8_STAGE(PG8_SA(0, 0), a2, voffA);
            PG8_BAR; PG8_WAIT_L(0); PG8_MMA(1, 0, At, B0); PG8_BAR; PG8_SCHED;
            PG8_STAGE(PG8_SB(0, 1), b2 + hstepB, voffB);
            PG8_WAIT_V(6); PG8_BAR; PG8_MMA(1, 1, At, B1); PG8_BAR;
            PG8_LDB(B0, 1, 0); PG8_SCHED; PG8_LDA(At, 1, 0); PG8_STAGE(PG8_SA(0, 1), a2 + hstepA, voffA);
            PG8_WAIT_L(8); PG8_BAR; PG8_WAIT_L(0); PG8_MMA(0, 0, At, B0); PG8_BAR; PG8_SCHED;
            PG8_LDB(B1, 1, 1); PG8_STAGE(PG8_SB(1, 0), b3, voffB);
            PG8_BAR; PG8_WAIT_L(0); PG8_MMA(0, 1, At, B1); PG8_BAR;
            PG8_LDA(At, 1, 1); PG8_STAGE(PG8_SA(1, 0), a3, voffA);
            PG8_BAR; PG8_WAIT_L(0); PG8_MMA(1, 0, At, B0); PG8_BAR; PG8_SCHED;
            PG8_STAGE(PG8_SB(1, 1), b3 + hstepB, voffB);
            PG8_WAIT_V(6); PG8_BAR; PG8_MMA(1, 1, At, B1); PG8_BAR;
            }
        }
        if constexpr (ALIGN_EPI) { if (wr == 0) PG8_BAR; }
        if constexpr (!Epi::AFTER_DRAIN) { E(acc, cur, wr, wc, fr, fq); S.done(cur); }
        if (!has_next) break;
#pragma unroll
        for (int a = 0; a < 2; ++a)
#pragma unroll
            for (int b = 0; b < 2; ++b)
#pragma unroll
                for (int m = 0; m < 4; ++m)
#pragma unroll
                    for (int n = 0; n < 2; ++n) acc[a][b][m][n] = (f32x4){0.f, 0.f, 0.f, 0.f};
        cur = nxt; cA = nA; cB = nB; ++ui;
        if constexpr (ALIGN_EPI) { if (wr == 1) PG8_BAR; }
    }
    PG8_WAIT_V(0);
    if constexpr (!ALIGN_EPI) { if (wr == 0) PG8_BAR; }
    PG8_BAR;
    if constexpr (Epi::AFTER_DRAIN) { E.fused(acc, cur, wr, wc, fr, fq, lds, wid, lane); S.done(cur); }
#undef PG8_SA
#undef PG8_SB
#undef PG8_STAGE
#undef PG8_LDA
#undef PG8_LDB
#undef PG8_MMA
#undef PG8_WAIT_V
#undef PG8_WAIT_L
#undef PG8_BAR
#undef PG8_SCHED
}
}

constexpr int NWAVES = 8;
constexpr int DM = 1024, MP = 16384, MS = 1024, M = MP + MS, DIN = 4608, DFF = 4096, SEQ = 8192, PAST = 1024, DSEQ = 64;
constexpr int C_Q = 0, C_K = 512, C_V = 1024, C_U = 1536, C_GR = 2048, C_GA = 2560, C_GB = 3584;
constexpr float EPS = 1e-6f;
constexpr float LOG2E = 1.4426950408889634f, LN2 = 0.6931471805599453f;
constexpr size_t MiB = 1u << 20;
constexpr size_t WS_CTL = 0;
constexpr size_t WS_WIN = 1 * MiB, WS_WA = 10 * MiB, WS_WB = 11 * MiB, WS_WO = 12 * MiB, WS_WUP = 14 * MiB, WS_WDN = 22 * MiB;
constexpr size_t WS_WR = 30 * MiB, WS_WI = 30 * MiB + 65536;
constexpr size_t WS_AGA = 31 * MiB, WS_AGB = 31 * MiB + 524288;
constexpr size_t WS_XN = 32 * MiB;
constexpr size_t WS_YA = 66 * MiB;
constexpr size_t WS_PROJ = 100 * MiB;
constexpr size_t WS_DOWN = WS_XN;
constexpr size_t WS_END = 253 * MiB;
constexpr int RING_BYTES = 131072, LDSCTL_OFF = RING_BYTES, MISC_OFF = LDSCTL_OFF + 320, LDS_BYTES = 147456;
constexpr int CW_BAR = 4096;
constexpr size_t CTL_ZERO_BYTES = 1u << 20;

#define GAS __attribute__((address_space(1)))
#define LAS __attribute__((address_space(3)))
#define DI __device__ __forceinline__
typedef unsigned short bf16;
typedef unsigned v4u __attribute__((ext_vector_type(4)));
typedef float f32x4 __attribute__((ext_vector_type(4)));
typedef float f32x16 __attribute__((ext_vector_type(16)));
typedef short bf16x8 __attribute__((ext_vector_type(8)));
typedef float f32x2_t __attribute__((ext_vector_type(2))); typedef __bf16 bf16x2_t __attribute__((ext_vector_type(2)));
DI unsigned pk2(float lo, float hi) { f32x2_t v = {lo, hi}; bf16x2_t b = __builtin_convertvector(v, bf16x2_t); return __builtin_bit_cast(unsigned, b); }
DI float bf2f(unsigned short h) { return __uint_as_float((unsigned)h << 16); }
DI float blo(unsigned w) { return __uint_as_float(w << 16); }
DI float bhi(unsigned w) { return __uint_as_float(w & 0xffff0000u); }
DI int crow(int i, int h) { return (i & 3) + 8 * (i >> 2) + 4 * h; }
#define MFMA32(a, b, c) __builtin_amdgcn_mfma_f32_32x32x16_bf16((a), (b), (c), 0, 0, 0)
DI void swap32(float v, float& lo, float& hi) { auto rr = __builtin_amdgcn_permlane32_swap(__float_as_uint(v), __float_as_uint(v), false, false); lo = __uint_as_float(rr[0]); hi = __uint_as_float(rr[1]); }
DI float sigm(float x) { return __builtin_amdgcn_rcpf(1.0f + __builtin_amdgcn_exp2f(-LOG2E * x)); }
DI float wave_sum(float v) {
#pragma unroll
    for (int o = 1; o < 64; o <<= 1) v += __shfl_xor(v, o);
    return v;
}

#define RLX_AGENT __ATOMIC_RELAXED, __HIP_MEMORY_SCOPE_AGENT
#define XB_TMO      128
#define XB_XCNT(j)  (256  + 64 * (j))
#define XB_XSUB(j)  (1280 + 64 * (j))
#define XB_XGEN(j)  (2304 + 64 * (j))
#define XB_TOP      3328
#define XB_TOPGEN   3392
#define XCD_BAR_WORDS 3456
#define XB_SPIN_CAP (1u << 18)

__device__ __forceinline__ unsigned xb_ld(unsigned* p)              { return __hip_atomic_load(p, __ATOMIC_RELAXED, __HIP_MEMORY_SCOPE_AGENT); }
__device__ __forceinline__ unsigned xb_add(unsigned* p, unsigned v) { return __hip_atomic_fetch_add(p, v, __ATOMIC_RELAXED, __HIP_MEMORY_SCOPE_AGENT); }
__device__ __forceinline__ unsigned xb_xcc_id() { return (unsigned)__builtin_amdgcn_s_getreg((3 << 11) | 20) & 0xFu; }
#define XB_SPIN(cond, bar) do { unsigned _sp = 0; while (cond) { __builtin_amdgcn_s_sleep(1); \
    if ((++_sp & 255u) == 0u) { if (xb_ld(&(bar)[XB_TMO])) break; if (_sp > XB_SPIN_CAP) { atomicAdd(&(bar)[XB_TMO], 1u); break; } } } } while (0)

struct XcdBarrier {
    unsigned* bar; unsigned x;
    volatile LAS unsigned* st;
};

__device__ __forceinline__ XcdBarrier xcd_barrier_post(unsigned* bar, volatile LAS unsigned* st) {
    XcdBarrier b; b.bar = bar; b.x = xb_xcc_id(); b.st = st;
    if (threadIdx.x == 0) (void)xb_add(&bar[XB_XCNT(b.x)], 1u);
    return b;
}
__device__ __forceinline__ void xcd_barrier_complete(unsigned* bar, unsigned x, unsigned& nloc, unsigned& nx) {
    const unsigned G = gridDim.x * gridDim.y * gridDim.z;
    unsigned sum, cnt, mine, sp = 0u;
    for (;;) {
        sum = 0u; cnt = 0u; mine = 0u;
#pragma unroll
        for (unsigned j = 0; j < 16; ++j) { const unsigned c = xb_ld(&bar[XB_XCNT(j)]); sum += c; cnt += (c > 0u) ? 1u : 0u; mine = (j == x) ? c : mine; }
        if (sum == G) break;
        __builtin_amdgcn_s_sleep(1);
        if ((++sp & 255u) == 0u) { if (xb_ld(&bar[XB_TMO])) break; if (sp > XB_SPIN_CAP) { atomicAdd(&bar[XB_TMO], 1u); break; } }
    }
    nloc = mine > 0u ? mine : 1u; nx = cnt > 0u ? cnt : 1u;
}

__device__ __forceinline__ void xcd_barrier(const XcdBarrier& b) {
    asm volatile("s_waitcnt vmcnt(0)" ::: "memory");
    __syncthreads();
    if (threadIdx.x == 0) {
        unsigned* bar = b.bar;
        __builtin_amdgcn_s_waitcnt(0);
        unsigned nloc = b.st[0], nx = b.st[1];
        if (nloc == 0u) { xcd_barrier_complete(bar, b.x, nloc, nx); b.st[0] = nloc; b.st[1] = nx; }
        const unsigned old = xb_add(&bar[XB_XSUB(b.x)], 1u);
        const unsigned gen = old / nloc;
        if (old + 1u == (gen + 1u) * nloc) {
            __builtin_amdgcn_fence(__ATOMIC_RELEASE, "agent");
            asm volatile("s_waitcnt vmcnt(0)" ::: "memory");
            const unsigned og = xb_add(&bar[XB_TOP], 1u);
            const unsigned tg = og / nx;
            if (og + 1u == (tg + 1u) * nx) xb_add(&bar[XB_TOPGEN], 1u);
            else XB_SPIN(xb_ld(&bar[XB_TOPGEN]) == tg, bar);
            __builtin_amdgcn_fence(__ATOMIC_ACQUIRE, "agent");
            xb_add(&bar[XB_XGEN(b.x)], 1u);
            asm volatile("s_waitcnt vmcnt(0)" ::: "memory");
        } else {
            XB_SPIN(xb_ld(&bar[XB_XGEN(b.x)]) == gen, bar);
            __builtin_amdgcn_fence(__ATOMIC_ACQUIRE, "agent");
            asm volatile("s_waitcnt vmcnt(0)" ::: "memory");
        }
    }
    __syncthreads();
}

struct Params { const float* in[23]; float* out; unsigned char* ws; };
enum { I_XP = 0, I_XS, I_CK, I_CV, I_SC, I_SH, I_WIN, I_GPM, I_WC, I_BC, I_WR, I_BR, I_WI, I_BI, I_LAM, I_WA, I_WB, I_WO, I_GPOM, I_GPF, I_WUP, I_WDN, I_GPOF };

DI void p0_transpose_item(const float* W, int K, int N, bf16* WT, LAS float* scr, int item, int lane) {
    const int nblk = N / 32, kb = item / nblk, nb = item % nblk, k0 = 64 * kb, n0 = 32 * nb;
#pragma unroll 8
    for (int i = 0; i < 32; ++i) { const int kk = 2 * i + (lane >> 5); scr[kk * 33 + (lane & 31)] = W[(size_t)(k0 + kk) * N + n0 + (lane & 31)]; }
    asm volatile("s_waitcnt lgkmcnt(0)" ::: "memory");
    const int c = lane & 7;
#pragma unroll
    for (int j = 0; j < 4; ++j) { const int n = (lane >> 3) + 8 * j; const LAS float* s = scr + (8 * c) * 33 + n;
        v4u o; o.x = pk2(s[0 * 33], s[1 * 33]); o.y = pk2(s[2 * 33], s[3 * 33]); o.z = pk2(s[4 * 33], s[5 * 33]); o.w = pk2(s[6 * 33], s[7 * 33]);
        *(v4u*)(WT + (size_t)(n0 + n) * K + k0 + 8 * c) = o; }
    asm volatile("s_waitcnt lgkmcnt(0)" ::: "memory");
}
DI const float* xrow_ptr(const Params& p, int m) { return m < MP ? p.in[I_XP] + (size_t)m * DM : p.in[I_XS] + (size_t)(m - MP) * DM; }
DI void rms_row_to_bf16(const float* xrow, const float* g, bf16* orow, int lane) {
    const f32x4* xr = (const f32x4*)xrow + lane; const f32x4* gr = (const f32x4*)g + lane;
    f32x4 v[4]; float s = 0.f;
#pragma unroll
    for (int j = 0; j < 4; ++j) { v[j] = xr[64 * j]; s += (v[j].x * v[j].x + v[j].y * v[j].y) + (v[j].z * v[j].z + v[j].w * v[j].w); }
    const float sc = 1.0f / sqrtf(wave_sum(s) * (1.f / DM) + EPS);
    unsigned long long* o8 = (unsigned long long*)orow + lane;
#pragma unroll
    for (int j = 0; j < 4; ++j) { const f32x4 gg = gr[64 * j]; o8[64 * j] = (unsigned long long)pk2(v[j].x * sc * gg.x, v[j].y * sc * gg.y) | ((unsigned long long)pk2(v[j].z * sc * gg.z, v[j].w * sc * gg.w) << 32); }
}
DI void p0_prologue(const Params& p, LAS unsigned char* lds, int gw, int NGW, int wave, int lane) {
    LAS float* scr = (LAS float*)(lds + wave * 16384);
    unsigned char* ws = p.ws;
    constexpr int I_IN = (DM / 64) * (DIN / 32), I_A = (512 / 64) * (DM / 32), I_O = (DM / 64) * (DM / 32), I_UP = (DM / 64) * (DFF / 32), I_DN = (DFF / 64) * (DM / 32), I_G = 16;
    constexpr int NITEMS = I_IN + 2 * I_A + I_O + I_UP + I_DN + 2 * I_G;
    for (int it = gw; it < NITEMS; it += NGW) {
        int r = it;
        if (r < I_IN) { p0_transpose_item(p.in[I_WIN], DM, DIN, (bf16*)(ws + WS_WIN), scr, r, lane); continue; } r -= I_IN;
        if (r < I_A) { p0_transpose_item(p.in[I_WA], 512, DM, (bf16*)(ws + WS_WA), scr, r, lane); continue; } r -= I_A;
        if (r < I_A) { p0_transpose_item(p.in[I_WB], 512, DM, (bf16*)(ws + WS_WB), scr, r, lane); continue; } r -= I_A;
        if (r < I_O) { p0_transpose_item(p.in[I_WO], DM, DM, (bf16*)(ws + WS_WO), scr, r, lane); continue; } r -= I_O;
        if (r < I_UP) { p0_transpose_item(p.in[I_WUP], DM, DFF, (bf16*)(ws + WS_WUP), scr, r, lane); continue; } r -= I_UP;
        if (r < I_DN) { p0_transpose_item(p.in[I_WDN], DFF, DM, (bf16*)(ws + WS_WDN), scr, r, lane); continue; } r -= I_DN;
        if (r < I_G) { p0_transpose_item(p.in[I_WR] + (r >> 1) * 4096, 64, 64, (bf16*)(ws + WS_WR) + (r >> 1) * 4096, scr, r & 1, lane); continue; } r -= I_G;
        p0_transpose_item(p.in[I_WI] + (r >> 1) * 4096, 64, 64, (bf16*)(ws + WS_WI) + (r >> 1) * 4096, scr, r & 1, lane);
    }
    bf16* XN = (bf16*)(ws + WS_XN);
    for (int m = gw; m < M; m += NGW) rms_row_to_bf16(xrow_ptr(p, m), p.in[I_GPM], XN + (size_t)m * DM, lane);
}

DI void attn_tile(const Params& p, int tile, int lane) {
    const bf16* PROJ = (const bf16*)(p.ws + WS_PROJ); bf16* OH = (bf16*)(p.ws + WS_XN);
    const int r = lane & 31, hh = lane >> 5;
    const bool samp = tile >= 4096;
    int b, h, pos0; size_t qrow0;
    if (!samp) { const int bh = tile >> 8; b = bh >> 3; h = bh & 7; pos0 = (tile & 255) * 32; qrow0 = (size_t)b * SEQ + pos0; }
    else { const int s = tile - 4096, bh = s >> 1; b = bh >> 3; h = bh & 7; pos0 = PAST + 32 * (s & 1); qrow0 = (size_t)MP + b * DSEQ + (pos0 - PAST); }
    const size_t krow0 = qrow0 - pos0;
    bf16x8 qf[4];
#pragma unroll
    for (int s = 0; s < 4; ++s) qf[s] = *(const bf16x8*)(PROJ + (qrow0 + r) * pg8::PROJ_LD + C_Q + h * 64 + 16 * s + 8 * hh);
    f32x16 o0, o1;
#pragma unroll
    for (int i = 0; i < 16; ++i) { o0[i] = 0.f; o1[i] = 0.f; }
    float R = 0.f;
    const int kb_hi = pos0 >> 5;
    for (int kb = kb_hi; kb >= 0; --kb) {
        const int p0 = kb * 32;
        bf16x8 kf[4], vf[2][2];
        if (!samp || p0 >= PAST) {
            const bf16* kr = PROJ + (krow0 + p0 + r) * pg8::PROJ_LD + C_K + h * 64 + 8 * hh;
#pragma unroll
            for (int s = 0; s < 4; ++s) kf[s] = *(const bf16x8*)(kr + 16 * s);
            const bf16* vb = PROJ + (krow0 + p0) * pg8::PROJ_LD + C_V + h * 64 + r;
#pragma unroll
            for (int s = 0; s < 2; ++s)
#pragma unroll
                for (int j = 0; j < 8; ++j) { const int key = 16 * s + 8 * (j >> 2) + 4 * hh + (j & 3); const bf16* vp = vb + (size_t)key * pg8::PROJ_LD;
                    vf[s][0][j] = (short)vp[0]; vf[s][1][j] = (short)vp[32]; }
        } else {
            const float* kr = p.in[I_CK] + ((size_t)(b * PAST + p0 + r) * 8 + h) * 64 + 8 * hh;
#pragma unroll
            for (int s = 0; s < 4; ++s) { const f32x4 a = *(const f32x4*)(kr + 16 * s), c = *(const f32x4*)(kr + 16 * s + 4);
                v4u w; w.x = pk2(a.x, a.y); w.y = pk2(a.z, a.w); w.z = pk2(c.x, c.y); w.w = pk2(c.z, c.w); kf[s] = __builtin_bit_cast(bf16x8, w); }
            const float* vb = p.in[I_CV] + ((size_t)(b * PAST + p0) * 8 + h) * 64 + r;
#pragma unroll
            for (int s = 0; s < 2; ++s) { float t0[8], t1[8];
#pragma unroll
                for (int j = 0; j < 8; ++j) { const int key = 16 * s + 8 * (j >> 2) + 4 * hh + (j & 3); const float* vp = vb + (size_t)key * 512; t0[j] = vp[0]; t1[j] = vp[32]; }
                v4u w0, w1; w0.x = pk2(t0[0], t0[1]); w0.y = pk2(t0[2], t0[3]); w0.z = pk2(t0[4], t0[5]); w0.w = pk2(t0[6], t0[7]);
                w1.x = pk2(t1[0], t1[1]); w1.y = pk2(t1[2], t1[3]); w1.z = pk2(t1[4], t1[5]); w1.w = pk2(t1[6], t1[7]);
                vf[s][0] = __builtin_bit_cast(bf16x8, w0); vf[s][1] = __builtin_bit_cast(bf16x8, w1); }
        }
        f32x16 st;
#pragma unroll
        for (int i = 0; i < 16; ++i) st[i] = 0.f;
#pragma unroll
        for (int s = 0; s < 4; ++s) st = MFMA32(kf[s], qf[s], st);
        const bool diag = (kb == kb_hi);
        float z[16], L[16];
#pragma unroll
        for (int i = 0; i < 16; ++i) { z[i] = st[i] * 0.125f;
            const float e = __builtin_amdgcn_exp2f(-fabsf(z[i]) * LOG2E);
            const float sp = fmaxf(z[i], 0.f) + LN2 * __builtin_amdgcn_logf(1.0f + e);
            const bool valid = !diag || (crow(i, hh) < r);
            L[i] = valid ? -sp : 0.f; }
        float Te[4], To[4];
#pragma unroll
        for (int g = 0; g < 4; ++g) { const float T = (L[4 * g] + L[4 * g + 1]) + (L[4 * g + 2] + L[4 * g + 3]); swap32(T, Te[g], To[g]); }
        float So[4], Sv[4]; So[3] = 0.f; Sv[3] = To[3]; So[2] = Sv[3] + Te[3]; Sv[2] = So[2] + To[2]; So[1] = Sv[2] + Te[2]; Sv[1] = So[1] + To[1]; So[0] = Sv[1] + Te[1]; Sv[0] = So[0] + To[0];
        const float total = Sv[0] + Te[0];
        float w[16];
#pragma unroll
        for (int g = 0; g < 4; ++g) { float run = R + (So[g] + (hh ? 0.f : To[g]));
#pragma unroll
            for (int q = 3; q >= 0; --q) { const int i = 4 * g + q; run += L[i];
                const bool valid = !diag || (crow(i, hh) < r);
                w[i] = valid ? __builtin_amdgcn_exp2f((z[i] + run) * LOG2E) : 0.f; } }
        R += total;
#pragma unroll
        for (int s = 0; s < 2; ++s) { v4u x; x.x = pk2(w[8 * s], w[8 * s + 1]); x.y = pk2(w[8 * s + 2], w[8 * s + 3]); x.z = pk2(w[8 * s + 4], w[8 * s + 5]); x.w = pk2(w[8 * s + 6], w[8 * s + 7]);
            const bf16x8 xs = __builtin_bit_cast(bf16x8, x);
            o0 = MFMA32(xs, vf[s][0], o0); o1 = MFMA32(xs, vf[s][1], o1); }
        if (__all(R < -110.f)) break;
    }
    bf16* ob = OH + qrow0 * DM + h * 64 + r;
#pragma unroll
    for (int i = 0; i < 16; ++i) { bf16* op = ob + (size_t)crow(i, hh) * DM; op[0] = (bf16)(pk2(o0[i], 0.f) & 0xffffu); op[32] = (bf16)(pk2(o1[i], 0.f) & 0xffffu); }
}

template <int PASS> DI void scan_unit(const Params& p, int unit, LAS float* scr, int lane) {
    const bf16* PROJ = (const bf16*)(p.ws + WS_PROJ); bf16* OH = (bf16*)(p.ws + WS_XN);
    float* AGA = (float*)(p.ws + WS_AGA); float* AGB = (float*)(p.ws + WS_AGB);
    const int r = lane & 31, hh = lane >> 5;
    const bool samp = unit >= 2048;
    int b, c, n; size_t row0;
    if (!samp) { b = unit >> 10; c = (unit >> 3) & 127; n = unit & 7; row0 = (size_t)b * SEQ + c * 64; }
    else { const int s = unit - 2048; b = s >> 3; c = 0; n = s & 7; row0 = (size_t)MP + b * DSEQ; }
    const int ch0 = n * 64;
#pragma unroll 1
    for (int it = 0; it < 8; ++it) { const int t = 32 * (it >> 2) + r, c0 = 16 * (it & 3) + 8 * hh;
        float a8[8];
        { const f32x4 b0 = *(const f32x4*)(p.in[I_BC] + ch0 + c0), b1 = *(const f32x4*)(p.in[I_BC] + ch0 + c0 + 4);
          a8[0] = b0.x; a8[1] = b0.y; a8[2] = b0.z; a8[3] = b0.w; a8[4] = b1.x; a8[5] = b1.y; a8[6] = b1.z; a8[7] = b1.w; }
#pragma unroll
        for (int j = 0; j < 4; ++j) { const int tt = t - 3 + j; float x8[8];
            if (tt >= 0 || c > 0) { const v4u xv = *(const v4u*)(PROJ + (row0 + tt) * pg8::PROJ_LD + C_U + ch0 + c0);
                x8[0] = blo(xv.x); x8[1] = bhi(xv.x); x8[2] = blo(xv.y); x8[3] = bhi(xv.y); x8[4] = blo(xv.z); x8[5] = bhi(xv.z); x8[6] = blo(xv.w); x8[7] = bhi(xv.w); }
            else if (samp) { const float* sp = p.in[I_SC] + (size_t)(b * 3 + 3 + tt) * 512 + ch0 + c0; const f32x4 s0 = *(const f32x4*)sp, s1 = *(const f32x4*)(sp + 4);
                x8[0] = s0.x; x8[1] = s0.y; x8[2] = s0.z; x8[3] = s0.w; x8[4] = s1.x; x8[5] = s1.y; x8[6] = s1.z; x8[7] = s1.w; }
            else {
#pragma unroll
                for (int k = 0; k < 8; ++k) x8[k] = 0.f; }
            const float* wp = p.in[I_WC] + j * 512 + ch0 + c0; const f32x4 w0 = *(const f32x4*)wp, w1 = *(const f32x4*)(wp + 4);
            a8[0] += x8[0] * w0.x; a8[1] += x8[1] * w0.y; a8[2] += x8[2] * w0.z; a8[3] += x8[3] * w0.w; a8[4] += x8[4] * w1.x; a8[5] += x8[5] * w1.y; a8[6] += x8[6] * w1.z; a8[7] += x8[7] * w1.w; }
        const int q0 = c0 >> 2, sw = t & 15;
        *(LAS f32x4*)(scr + t * 64 + ((q0 ^ sw) << 2)) = (f32x4){a8[0], a8[1], a8[2], a8[3]};
        *(LAS f32x4*)(scr + t * 64 + (((q0 + 1) ^ sw) << 2)) = (f32x4){a8[4], a8[5], a8[6], a8[7]}; }
    float hc = 0.f;
    if (PASS == 2) {
        if (samp) hc = p.in[I_SH][b * 512 + ch0 + lane];
        else { const float* pa = AGA + (size_t)b * 128 * 512 + ch0 + lane; const float* pb = AGB + (size_t)b * 128 * 512 + ch0 + lane;
            for (int cc = 0; cc < c; ++cc) hc = pa[(size_t)cc * 512] * hc + pb[(size_t)cc * 512]; }
    }
    const bf16* WRT = (const bf16*)(p.ws + WS_WR) + n * 4096; const bf16* WIT = (const bf16*)(p.ws + WS_WI) + n * 4096;
#pragma unroll 1
    for (int db = 0; db < 2; ++db) { const int d = 32 * db + r;
        bf16x8 wr[4], wi[4];
#pragma unroll
        for (int s = 0; s < 4; ++s) { wr[s] = *(const bf16x8*)(WRT + d * 64 + 16 * s + 8 * hh); wi[s] = *(const bf16x8*)(WIT + d * 64 + 16 * s + 8 * hh); }
        const float br = p.in[I_BR][ch0 + d], bi = p.in[I_BI][ch0 + d], lam = p.in[I_LAM][ch0 + d];
        const float cl = -8.0f * (fmaxf(-lam, 0.f) + log1pf(expf(-fabsf(lam))));
        float car = (PASS == 2) ? __shfl(hc, d) : 0.f, agA = 1.f, agB = 0.f;
#pragma unroll 1
        for (int tb = 0; tb < 2; ++tb) {
            f32x16 aR, aI;
#pragma unroll
            for (int i = 0; i < 16; ++i) { aR[i] = 0.f; aI[i] = 0.f; }
            { const int t = 32 * tb + r, sw = t & 15;
#pragma unroll
              for (int s = 0; s < 4; ++s) { const int q0 = (16 * s + 8 * hh) >> 2;
                const f32x4 x0 = *(const LAS f32x4*)(scr + t * 64 + ((q0 ^ sw) << 2)), x1 = *(const LAS f32x4*)(scr + t * 64 + (((q0 + 1) ^ sw) << 2));
                v4u w; w.x = pk2(x0.x, x0.y); w.y = pk2(x0.z, x0.w); w.z = pk2(x1.x, x1.y); w.w = pk2(x1.z, x1.w); const bf16x8 af = __builtin_bit_cast(bf16x8, w);
                aR = MFMA32(af, wr[s], aR); aI = MFMA32(af, wi[s], aI); } }
            float av[16], uv[16];
#pragma unroll
            for (int i = 0; i < 16; ++i) { const int t = 32 * tb + crow(i, hh);
                const float rg = sigm(aR[i] + br), ig = sigm(aI[i] + bi);
                const float la = cl * rg;
                av[i] = __builtin_amdgcn_exp2f(la * LOG2E);
                const float ucv = scr[t * 64 + (((d >> 2) ^ (t & 15)) << 2) + (d & 3)];
                uv[i] = sqrtf(-expm1f(2.0f * la)) * (ig * ucv); }
#pragma unroll
            for (int g = 0; g < 4; ++g) {
                float Ag = 1.f, Bg = 0.f;
#pragma unroll
                for (int q = 0; q < 4; ++q) { Bg = av[4 * g + q] * Bg + uv[4 * g + q]; Ag *= av[4 * g + q]; }
                float Al, Ah, Bl, Bh; swap32(Ag, Al, Ah); swap32(Bg, Bl, Bh);
                if (PASS == 1) { agB = Al * agB + Bl; agA *= Al; agB = Ah * agB + Bh; agA *= Ah; }
                else { const float hs_hi = Al * car + Bl; float hv = hh ? hs_hi : car;
#pragma unroll
                    for (int q = 0; q < 4; ++q) { const int i = 4 * g + q; const int t = 32 * tb + crow(i, hh);
                        hv = av[i] * hv + uv[i];
                        const float gr = bf2f(PROJ[(row0 + t) * pg8::PROJ_LD + C_GR + ch0 + d]);
                        const float ge = gr * sigm(1.5957691216057308f * (gr + 0.044715f * gr * gr * gr));
                        OH[(row0 + t) * DM + 512 + ch0 + d] = (bf16)(pk2(hv * ge, 0.f) & 0xffffu); }
                    car = Ah * hs_hi + Bh; }
            }
        }
        if (PASS == 1) { if (hh == 0) { AGA[((size_t)b * 128 + c) * 512 + ch0 + d] = agA; AGB[((size_t)b * 128 + c) * 512 + ch0 + d] = agB; } }
        else if (hh == 0 && (samp || c == 127)) { p.out[(samp ? pg8::OFF_HS : pg8::OFF_HP) + (size_t)b * 512 + ch0 + d] = car; }
    }
    if (PASS == 2 && (samp || c == 127)) {
#pragma unroll
        for (int j = 0; j < 3; ++j) p.out[(samp ? pg8::OFF_CS : pg8::OFF_CP) + (size_t)(b * 3 + j) * 512 + ch0 + lane] = bf2f(PROJ[(row0 + 61 + j) * pg8::PROJ_LD + C_U + ch0 + lane]);
    }
}

DI void norm_a_row(const Params& p, int m, int lane) {
    const f32x4* xr = (const f32x4*)xrow_ptr(p, m) + lane; const f32x4* mr = (const f32x4*)((const float*)(p.ws + WS_PROJ) + (size_t)m * DM) + lane;
    const f32x4* g1 = (const f32x4*)p.in[I_GPOM] + lane; const f32x4* g2 = (const f32x4*)p.in[I_GPF] + lane;
    f32x4 v[4], x1[4]; float s = 0.f;
#pragma unroll
    for (int j = 0; j < 4; ++j) { v[j] = mr[64 * j]; s += (v[j].x * v[j].x + v[j].y * v[j].y) + (v[j].z * v[j].z + v[j].w * v[j].w); }
    const float sc = 1.0f / sqrtf(wave_sum(s) * (1.f / DM) + EPS); float s2 = 0.f;
    f32x4* yo = (f32x4*)(p.out + pg8::OFF_Y + (size_t)m * DM) + lane;
#pragma unroll
    for (int j = 0; j < 4; ++j) { x1[j] = xr[64 * j] + v[j] * sc * g1[64 * j]; yo[64 * j] = x1[j]; s2 += (x1[j].x * x1[j].x + x1[j].y * x1[j].y) + (x1[j].z * x1[j].z + x1[j].w * x1[j].w); }
    const float sc2 = 1.0f / sqrtf(wave_sum(s2) * (1.f / DM) + EPS);
    unsigned long long* o8 = (unsigned long long*)((bf16*)(p.ws + WS_XN) + (size_t)m * DM) + lane;
#pragma unroll
    for (int j = 0; j < 4; ++j) { const f32x4 gg = g2[64 * j]; o8[64 * j] = (unsigned long long)pk2(x1[j].x * sc2 * gg.x, x1[j].y * sc2 * gg.y) | ((unsigned long long)pk2(x1[j].z * sc2 * gg.z, x1[j].w * sc2 * gg.w) << 32); }
}
DI void norm_b_row(const Params& p, int m, int lane) {
    const f32x4* dr = (const f32x4*)((const float*)(p.ws + WS_DOWN) + (size_t)m * DM) + lane; const f32x4* g = (const f32x4*)p.in[I_GPOF] + lane;
    f32x4* yo = (f32x4*)(p.out + pg8::OFF_Y + (size_t)m * DM) + lane;
    f32x4 v[4]; float s = 0.f;
#pragma unroll
    for (int j = 0; j < 4; ++j) { v[j] = dr[64 * j]; s += (v[j].x * v[j].x + v[j].y * v[j].y) + (v[j].z * v[j].z + v[j].w * v[j].w); }
    const float sc = 1.0f / sqrtf(wave_sum(s) * (1.f / DM) + EPS);
#pragma unroll
    for (int j = 0; j < 4; ++j) yo[64 * j] = yo[64 * j] + v[j] * sc * g[64 * j];
}

__global__ void __launch_bounds__(NWAVES * 64, 2) fwd_mega(Params p) {
    extern __shared__ __attribute__((aligned(16))) unsigned char lds_raw[];
    cg::grid_group grid = cg::this_grid();
    LAS unsigned char* lds = (LAS unsigned char*)lds_raw;
    const int tid = threadIdx.x, lane = tid & 63, wave = __builtin_amdgcn_readfirstlane(tid >> 6);
    const int G = gridDim.x, bx = blockIdx.x;
    const int vcu = (G % 8 == 0) ? (bx % 8) * (G / 8) + bx / 8 : bx;
    const int gw = vcu * NWAVES + wave, NGW = G * NWAVES;
    unsigned char* ws = p.ws;
    for (int u = tid; u < (LDS_BYTES - LDSCTL_OFF) / 4; u += NWAVES * 64) ((LAS unsigned*)(lds + LDSCTL_OFF))[u] = 0u;
    __syncthreads();
    const XcdBarrier bar = xcd_barrier_post((unsigned*)(ws + WS_CTL) + CW_BAR, (volatile LAS unsigned*)(lds + MISC_OFF) + 8);
    pg8::bf16_t* PROJ = (pg8::bf16_t*)(ws + WS_PROJ); pg8::bf16_t* XN = (pg8::bf16_t*)(ws + WS_XN); pg8::bf16_t* YA = (pg8::bf16_t*)(ws + WS_YA);

    p0_prologue(p, lds, gw, NGW, wave, lane);
    grid.sync();
    { pg8::Gemm g{XN, (const pg8::bf16_t*)(ws + WS_WIN), M, DIN, DM, DM}; pg8::StaticOrder S; S.init(M, DIN, G, bx);
      pg8::EpiProj E{PROJ, p.out};
      pg8::gemm_phase<pg8::EpiProj, pg8::StaticOrder, true, true>(lds, g, S, E); }
    xcd_barrier(bar);
    { LAS float* scr = (LAS float*)(lds + wave * 16384);
      for (int u = gw; u < 2048; u += NGW) scan_unit<1>(p, u, scr, lane); }
    xcd_barrier(bar);
    { LAS float* scr = (LAS float*)(lds + wave * 16384);
      for (int u = gw; u < 2176; u += NGW) scan_unit<2>(p, u, scr, lane);
      for (int t = gw; t < 4352; t += NGW) attn_tile(p, t, lane); }
    xcd_barrier(bar);
    { pg8::Gemm g{XN, (const pg8::bf16_t*)(ws + WS_WA), M, DM, 512, DM}; pg8::StaticOrder S; S.init(M, DM, G, bx);
      pg8::EpiGate<0> E{YA, PROJ};
      pg8::gemm_phase<pg8::EpiGate<0>, pg8::StaticOrder, true, true>(lds, g, S, E); }
    xcd_barrier(bar);
    { pg8::Gemm g{XN + 512, (const pg8::bf16_t*)(ws + WS_WB), M, DM, 512, DM}; pg8::StaticOrder S; S.init(M, DM, G, bx);
      pg8::EpiGate<1> E{YA, PROJ};
      pg8::gemm_phase<pg8::EpiGate<1>, pg8::StaticOrder, true, true>(lds, g, S, E); }
    xcd_barrier(bar);
    { pg8::Gemm g{YA, (const pg8::bf16_t*)(ws + WS_WO), M, DM, DM, DM}; pg8::StaticOrder S; S.init(M, DM, G, bx);
      pg8::EpiF32 E{(float*)(ws + WS_PROJ), DM};
      pg8::gemm_phase<pg8::EpiF32, pg8::StaticOrder, true, true>(lds, g, S, E); }
    xcd_barrier(bar);
    for (int m = gw; m < M; m += NGW) norm_a_row(p, m, lane);
    xcd_barrier(bar);
    { pg8::Gemm g{XN, (const pg8::bf16_t*)(ws + WS_WUP), M, DFF, DM, DM}; pg8::StaticOrder S; S.init(M, DFF, G, bx);
      pg8::EpiRelu2 E{PROJ, DFF};
      pg8::gemm_phase<pg8::EpiRelu2, pg8::StaticOrder, true, true>(lds, g, S, E); }
    xcd_barrier(bar);
    { pg8::Gemm g{PROJ, (const pg8::bf16_t*)(ws + WS_WDN), M, DM, DFF, DFF}; pg8::StaticOrder S; S.init(M, DM, G, bx);
      pg8::EpiF32 E{(float*)(ws + WS_DOWN), DM};
      pg8::gemm_phase<pg8::EpiF32, pg8::StaticOrder, true, true>(lds, g, S, E); }
    xcd_barrier(bar);
    for (int m = gw; m < M; m += NGW) norm_b_row(p, m, lane);
}

extern "C" void kernel_launch(void* const* d_in, const int* in_sizes, int n_in, void* d_out, int out_size, void* d_ws, size_t ws_size, hipStream_t stream) {
    static int grid = 0;
    if (grid == 0) {
        if (n_in != 23 || in_sizes[0] != MP * DM || (size_t)out_size != pg8::OUT_TOTAL || ws_size < WS_END) { fprintf(stderr, "kernel_launch: unexpected shapes (n_in %d, in0 %d, out %d, ws %zu)\n", n_in, n_in > 0 ? in_sizes[0] : -1, out_size, ws_size); grid = -1; return; }
        int dev = 0, cus = 0, per_cu = 0;
        if (hipGetDevice(&dev) != hipSuccess || hipDeviceGetAttribute(&cus, hipDeviceAttributeMultiprocessorCount, dev) != hipSuccess) { grid = -1; return; }
        if (hipFuncSetAttribute((const void*)fwd_mega, hipFuncAttributeMaxDynamicSharedMemorySize, LDS_BYTES) != hipSuccess) { fprintf(stderr, "kernel_launch: hipFuncSetAttribute failed\n"); grid = -1; return; }
        if (hipOccupancyMaxActiveBlocksPerMultiprocessor(&per_cu, (const void*)fwd_mega, NWAVES * 64, LDS_BYTES) != hipSuccess || per_cu < 1) { fprintf(stderr, "kernel_launch: occupancy query says %d blocks per CU\n", per_cu); per_cu = 1; }
        (void)hipGetLastError();
        grid = cus;
    }
    if (grid < 0) return;
    if (hipMemsetAsync((char*)d_ws + WS_CTL, 0, CTL_ZERO_BYTES, stream) != hipSuccess) { fprintf(stderr, "kernel_launch: hipMemsetAsync failed\n"); return; }
    Params prm{};
    for (int i = 0; i < 23; ++i) prm.in[i] = (const float*)d_in[i];
    prm.out = (float*)d_out; prm.ws = (unsigned char*)d_ws;
    void* args[] = {&prm};
    hipError_t e = hipLaunchCooperativeKernel((const void*)fwd_mega, dim3(grid), dim3(NWAVES * 64), args, LDS_BYTES, stream);
    if (e != hipSuccess) fprintf(stderr, "kernel_launch: cooperative launch failed: %s (grid %d)\n", hipGetErrorString(e), grid);
}
```

```cpp
#include <hip/hip_runtime.h>
#include <hip/hip_cooperative_groups.h>
#include <cstdio>
#include <cstdint>
namespace cg = cooperative_groups;
namespace pg8 {
#define PG8_LAS __attribute__((address_space(3)))
typedef unsigned short bf16_t;
typedef short bf16x8 __attribute__((ext_vector_type(8)));
typedef float f32x4 __attribute__((ext_vector_type(4)));
typedef unsigned u32x4 __attribute__((ext_vector_type(4)));
constexpr int BM = 256, BK = 64, HALF = 128, HTB = HALF * BK * 2  , STAGE_BYTES = 8 * HTB, NXCD = 8, WGM = 8;

__host__ __device__ __forceinline__ int lds_byte(int r, int c) { const int st = (r >> 4) * 2 + (c >> 5), rr = r & 15, cc = c & 31, ob = rr * 64 + cc * 2; return st * 1024 + (ob ^ (((ob >> 9) & 1) << 5)); }
__host__ __device__ __forceinline__ void stage_rc(int b, int& R, int& C) { const int st = b / 1024, sb = b % 1024, swz = sb ^ (((sb >> 9) & 1) << 5); R = (st >> 1) * 16 + swz / 64; C = (st & 1) * 32 + (swz % 64) / 2; }
__host__ __device__ __forceinline__ int perm32(int rho) { const int n = rho >> 4, i = rho & 15; return 8 * (i >> 2) + 4 * n + (i & 3); }

struct Unit { int pm, pn, k0, nt, ks; };
struct Gemm { const bf16_t* A; const bf16_t* Bt; int M, N, K, lda; };

struct StaticOrder {
    int nM, nN, nwg, G, c, ntf;
    __host__ __device__ void init(int M, int N, int G_, int c_, int ntf_) { nM = M / BM; nN = N / BM; nwg = nM * nN; G = G_; c = c_; ntf = ntf_; }
    __host__ __device__ bool next(int i, Unit& u) const {
        const long L = (long)i * G + c; if (L >= nwg) return false;
        int wgid = (int)L; { const int q = nwg / NXCD, r = nwg % NXCD, xcd = wgid % NXCD, off = wgid / NXCD; wgid = (xcd < r ? xcd * (q + 1) : r * (q + 1) + (xcd - r) * q) + off; }
        const int nig = WGM * nN, gid = wgid / nig, fm = gid * WGM, gsz = (nM - fm) < WGM ? (nM - fm) : WGM;
        u.pm = fm + ((wgid % nig) % gsz); u.pn = (wgid % nig) / gsz; u.k0 = 0; u.nt = ntf; u.ks = 0; return true;
    }
    __device__ __forceinline__ void a_ready(const Unit&) const {}
    __device__ __forceinline__ void done(const Unit&) const {}
};

struct OrderSplit {
    StaticOrder so; int c, nsplit, nts;
    __host__ __device__ void init(int N, int G_, int c_, int ntf_, int nsplit_) { so.init(16384, N, G_, c_, ntf_); c = c_; nsplit = nsplit_; nts = ntf_ / nsplit_; }
    __host__ __device__ bool next(int i, Unit& u) const {
        const bool has_sub = c < 16 * nsplit;
        if (has_sub && i == 0) { const int tile = c / nsplit, ks = c % nsplit; u.pm = 64 + (tile >> 2); u.pn = tile & 3; u.k0 = ks * nts * BK; u.nt = nts; u.ks = ks; return true; }
        return so.next(i - (has_sub ? 1 : 0), u);
    }
    __device__ __forceinline__ void a_ready(const Unit&) const {}
    __device__ __forceinline__ void done(const Unit&) const {}
};
struct OrderPair {
    StaticOrder so;
    __host__ __device__ void init(int M, int N, int G_, int c_) { so.init(M, N, G_, c_, 8); }
    __host__ __device__ bool next(int i, Unit& u) const { if (!so.next(i >> 1, u)) return false; u.ks = i & 1; u.k0 = (i & 1) * 512; u.nt = 8; return true; }
    __device__ __forceinline__ void a_ready(const Unit&) const {}
    __device__ __forceinline__ void done(const Unit&) const {}
};
__device__ __forceinline__ unsigned cvt_pk_bf16(float lo, float hi) { unsigned r; asm volatile("v_cvt_pk_bf16_f32 %0, %1, %2" : "=v"(r) : "v"(lo), "v"(hi)); return r; }
__device__ __forceinline__ float bf_lo(unsigned w) { return __uint_as_float(w << 16); }
__device__ __forceinline__ float bf_hi(unsigned w) { return __uint_as_float(w & 0xffff0000u); }
__device__ __forceinline__ float sigmoidf_(float x) { return __builtin_amdgcn_rcpf(1.0f + __builtin_amdgcn_exp2f(-1.4426950408889634f * x)); }
constexpr int PROJ_LD = 4608;
constexpr size_t OFF_Y = 0, OFF_KP = 17825792, OFF_VP = 26214400, OFF_CP = 34603008, OFF_HP = 34606080, OFF_KS = 34607104, OFF_VS = 35131392, OFF_CS = 35655680, OFF_HS = 35680256, OUT_TOTAL = 35688448;

struct EpiProj {
    static constexpr bool PERM = true, AFTER_DRAIN = false;
    bf16_t* P; float* out;
    __device__ __forceinline__ void operator()(const f32x4 (&acc)[2][2][4][2], const Unit& u, int wr, int wc, int fr, int fq) const {
        const int row0 = u.pm * BM + wr * 64 + fr, col0 = u.pn * BM + wc * 32 + 8 * fq;
        const bool iskv = (u.pn >= 2 && u.pn < 6), isv = u.pn >= 4, samp = u.pm >= 64;
        float* kvb = out + (samp ? (isv ? OFF_VS : OFF_KS) : (isv ? OFF_VP : OFF_KP)) - (samp ? (size_t)16384 * 512 : 0) + (col0 - (isv ? 1024 : 512));
#pragma unroll
        for (int ai = 0; ai < 2; ++ai)
#pragma unroll
            for (int m = 0; m < 4; ++m) { const int row = row0 + ai * HALF + m * 16; bf16_t* rowp = P + (size_t)row * PROJ_LD + col0;
#pragma unroll
                for (int bj = 0; bj < 2; ++bj) { const f32x4 v0 = acc[ai][bj][m][0], v1 = acc[ai][bj][m][1];
                    u32x4 w; w.x = cvt_pk_bf16(v0[0], v0[1]); w.y = cvt_pk_bf16(v0[2], v0[3]); w.z = cvt_pk_bf16(v1[0], v1[1]); w.w = cvt_pk_bf16(v1[2], v1[3]);
                    *(u32x4*)(rowp + bj * HALF) = w;
                    if (iskv) { float* d = kvb + (size_t)row * 512 + bj * HALF; *(f32x4*)d = v0; *(f32x4*)(d + 4) = v1; } } }
    }
};
struct EpiGate {
    static constexpr bool PERM = true, AFTER_DRAIN = false;
    bf16_t* Y; const bf16_t* P;
    __device__ __forceinline__ void operator()(const f32x4 (&acc)[2][2][4][2], const Unit& u, int wr, int wc, int fr, int fq) const {
        const int row0 = u.pm * BM + wr * 64 + fr, col0 = u.pn * BM + wc * 32 + 8 * fq; const int mode = u.ks;
#pragma unroll
        for (int ai = 0; ai < 2; ++ai)
#pragma unroll
            for (int m = 0; m < 4; ++m) { const int row = row0 + ai * HALF + m * 16; bf16_t* rowp = Y + (size_t)row * 1024 + col0; const bf16_t* gp = P + (size_t)row * PROJ_LD + (mode == 0 ? 2560 : 3584) + col0;
#pragma unroll
                for (int bj = 0; bj < 2; ++bj) { const f32x4 v0 = acc[ai][bj][m][0], v1 = acc[ai][bj][m][1];
                    const u32x4 g = *(const u32x4*)(gp + bj * HALF);
                    float o[8] = { sigmoidf_(bf_lo(g.x)) * v0[0], sigmoidf_(bf_hi(g.x)) * v0[1], sigmoidf_(bf_lo(g.y)) * v0[2], sigmoidf_(bf_hi(g.y)) * v0[3],
                                   sigmoidf_(bf_lo(g.z)) * v1[0], sigmoidf_(bf_hi(g.z)) * v1[1], sigmoidf_(bf_lo(g.w)) * v1[2], sigmoidf_(bf_hi(g.w)) * v1[3] };
                    if (mode == 1) { const unsigned long long* yp = (const unsigned long long*)(rowp + bj * HALF);
                        const unsigned long long y0 = __hip_atomic_load(yp, __ATOMIC_RELAXED, __HIP_MEMORY_SCOPE_AGENT), y1 = __hip_atomic_load(yp + 1, __ATOMIC_RELAXED, __HIP_MEMORY_SCOPE_AGENT);
                        const unsigned yx = (unsigned)y0, yy = (unsigned)(y0 >> 32), yz = (unsigned)y1, yw = (unsigned)(y1 >> 32);
                        o[0] += bf_lo(yx); o[1] += bf_hi(yx); o[2] += bf_lo(yy); o[3] += bf_hi(yy); o[4] += bf_lo(yz); o[5] += bf_hi(yz); o[6] += bf_lo(yw); o[7] += bf_hi(yw); }
                    u32x4 w; w.x = cvt_pk_bf16(o[0], o[1]); w.y = cvt_pk_bf16(o[2], o[3]); w.z = cvt_pk_bf16(o[4], o[5]); w.w = cvt_pk_bf16(o[6], o[7]);
                    *(u32x4*)(rowp + bj * HALF) = w; } }
    }
};
struct EpiF32P {
    static constexpr bool PERM = true, AFTER_DRAIN = false;
    float* O; float* PART;
    __device__ __forceinline__ void operator()(const f32x4 (&acc)[2][2][4][2], const Unit& u, int wr, int wc, int fr, int fq) const {
        const int row0 = u.pm * BM + wr * 64 + fr, col0 = u.pn * BM + wc * 32 + 8 * fq;
        float* base = (u.pm >= 64) ? PART + (size_t)u.ks * (1024 * 1024) - (size_t)16384 * 1024 : O;
#pragma unroll
        for (int ai = 0; ai < 2; ++ai)
#pragma unroll
            for (int m = 0; m < 4; ++m) { float* rowp = base + (size_t)(row0 + ai * HALF + m * 16) * 1024 + col0;
#pragma unroll
                for (int bj = 0; bj < 2; ++bj) { *(f32x4*)(rowp + bj * HALF) = acc[ai][bj][m][0]; *(f32x4*)(rowp + bj * HALF + 4) = acc[ai][bj][m][1]; } }
    }
};
struct EpiRelu2 {
    static constexpr bool PERM = true, AFTER_DRAIN = false;
    bf16_t* O; int ldc;
    __device__ __forceinline__ void operator()(const f32x4 (&acc)[2][2][4][2], const Unit& u, int wr, int wc, int fr, int fq) const {
        const int row0 = u.pm * BM + wr * 64 + fr, col0 = u.pn * BM + wc * 32 + 8 * fq;
#pragma unroll
        for (int ai = 0; ai < 2; ++ai)
#pragma unroll
            for (int m = 0; m < 4; ++m) { bf16_t* rowp = O + (size_t)(row0 + ai * HALF + m * 16) * ldc + col0;
#pragma unroll
                for (int bj = 0; bj < 2; ++bj) { f32x4 v0 = acc[ai][bj][m][0], v1 = acc[ai][bj][m][1];
#pragma unroll
                    for (int e = 0; e < 4; ++e) { const float a = fmaxf(v0[e], 0.f), b = fmaxf(v1[e], 0.f); v0[e] = a * a; v1[e] = b * b; }
                    u32x4 w; w.x = cvt_pk_bf16(v0[0], v0[1]); w.y = cvt_pk_bf16(v0[2], v0[3]); w.z = cvt_pk_bf16(v1[0], v1[1]); w.w = cvt_pk_bf16(v1[2], v1[3]);
                    *(u32x4*)(rowp + bj * HALF) = w; } }
    }
};
template <class Epi, class Sched, bool ALIGN_EPI = false, bool SP2 = false>
__device__ __forceinline__ void gemm_phase(PG8_LAS unsigned char* lds, const Gemm g, const Sched& S, const Epi& E) {
    const int tid = threadIdx.x, wid = __builtin_amdgcn_readfirstlane(tid >> 6), lane = tid & 63, wr = wid >> 2, wc = wid & 3, fr = lane & 15, fq = lane >> 4;
    const int K = g.K;
    unsigned voffA[2], voffB[2];
#pragma unroll
    for (int i = 0; i < 2; ++i) { int R, C; stage_rc(tid * 16 + i * 8192, R, C); const int Rb = Epi::PERM ? ((R & ~31) + perm32(R & 31)) : R;
        voffA[i] = (unsigned)(R * g.lda + C) * 2u; voffB[i] = (unsigned)(Rb * K + C) * 2u; }
    const size_t kstep = (size_t)(BK * 2);
    const size_t hstepA = (size_t)HALF * g.lda * 2, hstepB = (size_t)HALF * K * 2;
    const size_t tstepA = 2 * hstepA, tstepB = 2 * hstepB;
    const unsigned ldsw = (unsigned)wid * 1024u;
    const int aoff = lds_byte(wr * 64 + fr, fq * 8), boff = lds_byte(wc * 32 + fr, fq * 8);
#define PG8_SA(b, h) (((b) * 2 + (h)) * HTB)
#define PG8_SB(b, h) ((4 + (b) * 2 + (h)) * HTB)
#define PG8_STAGE(bufoff, gbase, voff) do { _Pragma("unroll") for (int _i = 0; _i < 2; ++_i) \
        __builtin_amdgcn_global_load_lds((const unsigned*)((const char*)(gbase) + (voff)[_i]), (PG8_LAS unsigned*)(lds + (bufoff) + ldsw + _i * 8192), 16, 0, 0); } while (0)
#define PG8_LDA(dst, b, h) do { _Pragma("unroll") for (int m = 0; m < 4; ++m) _Pragma("unroll") for (int k = 0; k < 2; ++k) dst[m][k] = *(const PG8_LAS bf16x8*)(lds + PG8_SA(b, h) + aoff + m * 2048 + k * 1024); } while (0)
#define PG8_LDB(dst, b, h) do { _Pragma("unroll") for (int n = 0; n < 2; ++n) _Pragma("unroll") for (int k = 0; k < 2; ++k) dst[n][k] = *(const PG8_LAS bf16x8*)(lds + PG8_SB(b, h) + boff + n * 2048 + k * 1024); } while (0)
#define PG8_MMA(ai, bj, At, Bt) do { __builtin_amdgcn_s_setprio(1); _Pragma("unroll") for (int m = 0; m < 4; ++m) _Pragma("unroll") for (int n = 0; n < 2; ++n) _Pragma("unroll") for (int k = 0; k < 2; ++k) \
        acc[ai][bj][m][n] = __builtin_amdgcn_mfma_f32_16x16x32_bf16(Bt[n][k], At[m][k], acc[ai][bj][m][n], 0, 0, 0); __builtin_amdgcn_s_setprio(0); } while (0)
#define PG8_WAIT_V(n) asm volatile("s_waitcnt vmcnt(" #n ")" ::: "memory")
#define PG8_WAIT_L(n) asm volatile("s_waitcnt lgkmcnt(" #n ")" ::: "memory")
#define PG8_BAR __builtin_amdgcn_s_barrier()
#define PG8_SCHED __builtin_amdgcn_sched_barrier(0)
    Unit cur, nxt; int ui = 0;
    if (!S.next(0, cur)) return;
    f32x4 acc[2][2][4][2];
#pragma unroll
    for (int a = 0; a < 2; ++a)
#pragma unroll
        for (int b = 0; b < 2; ++b)
#pragma unroll
            for (int m = 0; m < 4; ++m)
#pragma unroll
                for (int n = 0; n < 2; ++n) acc[a][b][m][n] = (f32x4){0.f, 0.f, 0.f, 0.f};
    bf16x8 At[4][2], B0[2][2], B1[2][2];
    const char* cA = (const char*)g.A + (size_t)cur.pm * tstepA + (size_t)cur.k0 * 2; const char* cB = (const char*)g.Bt + (size_t)cur.pn * tstepB + (size_t)cur.k0 * 2;
    S.a_ready(cur);
    if constexpr (SP2) {
        PG8_STAGE(PG8_SB(0, 0), cB, voffB); PG8_STAGE(PG8_SB(0, 1), cB + hstepB, voffB); PG8_STAGE(PG8_SA(0, 0), cA, voffA); PG8_STAGE(PG8_SA(0, 1), cA + hstepA, voffA);
        if (wr == 1) PG8_BAR;
        PG8_WAIT_V(2); PG8_BAR;
        PG8_STAGE(PG8_SB(1, 0), cB + kstep, voffB); PG8_STAGE(PG8_SA(1, 0), cA + kstep, voffA); PG8_STAGE(PG8_SB(1, 1), cB + hstepB + kstep, voffB);
        PG8_WAIT_V(6); PG8_BAR;
    } else {
        PG8_STAGE(PG8_SB(0, 0), cB, voffB); PG8_STAGE(PG8_SA(0, 0), cA, voffA); PG8_STAGE(PG8_SB(0, 1), cB + hstepB, voffB); PG8_STAGE(PG8_SA(0, 1), cA + hstepA, voffA);
        if (wr == 1) PG8_BAR;
        PG8_WAIT_V(4); PG8_BAR;
        PG8_STAGE(PG8_SB(1, 0), cB + kstep, voffB); PG8_STAGE(PG8_SA(1, 0), cA + kstep, voffA); PG8_STAGE(PG8_SB(1, 1), cB + hstepB + kstep, voffB);
        PG8_WAIT_V(6); PG8_BAR;
    }
    for (;;) {
        const bool has_next = S.next(ui + 1, nxt);
        const char* nA = has_next ? (const char*)g.A + (size_t)nxt.pm * tstepA + (size_t)nxt.k0 * 2 : cA; const char* nB = has_next ? (const char*)g.Bt + (size_t)nxt.pn * tstepB + (size_t)nxt.k0 * 2 : cB;
        const int nt = cur.nt;
        for (int t = 0; t < nt; t += 2) {
            const bool last = (t == nt - 2);
            const char* a1 = cA + (size_t)(t + 1) * kstep;
            const char* a2 = last ? nA : cA + (size_t)(t + 2) * kstep; const char* b2 = last ? nB : cB + (size_t)(t + 2) * kstep;
            const char* a3 = a2 + kstep; const char* b3 = b2 + kstep;
            if (last && has_next) S.a_ready(nxt);
            if constexpr (SP2) {
            PG8_LDB(B0, 0, 0); PG8_LDB(B1, 0, 1); PG8_SCHED; PG8_LDA(At, 0, 0); PG8_STAGE(PG8_SA(1, 1), a1 + hstepA, voffA);
            PG8_WAIT_V(8); PG8_WAIT_L(0); PG8_BAR; PG8_MMA(0, 0, At, B0); PG8_MMA(0, 1, At, B1); PG8_BAR; PG8_SCHED;
            PG8_LDA(At, 0, 1); PG8_STAGE(PG8_SB(0, 0), b2, voffB); PG8_STAGE(PG8_SB(0, 1), b2 + hstepB, voffB); PG8_STAGE(PG8_SA(0, 0), a2, voffA);
            PG8_WAIT_V(8); PG8_WAIT_L(0); PG8_BAR; PG8_MMA(1, 0, At, B0); PG8_MMA(1, 1, At, B1); PG8_BAR; PG8_SCHED;
            PG8_LDB(B0, 1, 0); PG8_LDB(B1, 1, 1); PG8_SCHED; PG8_LDA(At, 1, 0); PG8_STAGE(PG8_SA(0, 1), a2 + hstepA, voffA);
            PG8_WAIT_V(8); PG8_WAIT_L(0); PG8_BAR; PG8_MMA(0, 0, At, B0); PG8_MMA(0, 1, At, B1); PG8_BAR; PG8_SCHED;
            PG8_LDA(At, 1, 1); PG8_STAGE(PG8_SB(1, 0), b3, voffB); PG8_STAGE(PG8_SB(1, 1), b3 + hstepB, voffB); PG8_STAGE(PG8_SA(1, 0), a3, voffA);
            PG8_WAIT_V(8); PG8_WAIT_L(0); PG8_BAR; PG8_MMA(1, 0, At, B0); PG8_MMA(1, 1, At, B1); PG8_BAR; PG8_SCHED;
            } else {
            PG8_LDB(B0, 0, 0); PG8_SCHED; PG8_LDA(At, 0, 0); PG8_STAGE(PG8_SA(1, 1), a1 + hstepA, voffA);
            PG8_WAIT_L(8); PG8_BAR; PG8_WAIT_L(0); PG8_MMA(0, 0, At, B0); PG8_BAR; PG8_SCHED;
            PG8_LDB(B1, 0, 1); PG8_STAGE(PG8_SB(0, 0), b2, voffB);
            PG8_BAR; PG8_WAIT_L(0); PG8_MMA(0, 1, At, B1); PG8_BAR;
            PG8_LDA(At, 0, 1); PG8_STAGE(PG8_SA(0, 0), a2, voffA);
            PG8_BAR; PG8_WAIT_L(0); PG8_MMA(1, 0, At, B0); PG8_BAR; PG8_SCHED;
            PG8_STAGE(PG8_SB(0, 1), b2 + hstepB, voffB);
            PG8_WAIT_V(6); PG8_BAR; PG8_MMA(1, 1, At, B1); PG8_BAR;
            PG8_LDB(B0, 1, 0); PG8_SCHED; PG8_LDA(At, 1, 0); PG8_STAGE(PG8_SA(0, 1), a2 + hstepA, voffA);
            PG8_WAIT_L(8); PG8_BAR; PG8_WAIT_L(0); PG8_MMA(0, 0, At, B0); PG8_BAR; PG8_SCHED;
            PG8_LDB(B1, 1, 1); PG8_STAGE(PG8_SB(1, 0), b3, voffB);
            PG8_BAR; PG8_WAIT_L(0); PG8_MMA(0, 1, At, B1); PG8_BAR;
            PG8_LDA(At, 1, 1); PG8_STAGE(PG8_SA(1, 0), a3, voffA);
            PG8_BAR; PG8_WAIT_L(0); PG8_MMA(1, 0, At, B0); PG8_BAR; PG8_SCHED;
            PG8_STAGE(PG8_SB(1, 1), b3 + hstepB, voffB);
            PG8_WAIT_V(6); PG8_BAR; PG8_MMA(1, 1, At, B1); PG8_BAR;
            }
        }
        if constexpr (ALIGN_EPI) { if (wr == 0) PG8_BAR; }
        if constexpr (!Epi::AFTER_DRAIN) { E(acc, cur, wr, wc, fr, fq); S.done(cur); }
        if (!has_next) break;
#pragma unroll
        for (int a = 0; a < 2; ++a)
#pragma unroll
            for (int b = 0; b < 2; ++b)
#pragma unroll
                for (int m = 0; m < 4; ++m)
#pragma unroll
                    for (int n = 0; n < 2; ++n) acc[a][b][m][n] = (f32x4){0.f, 0.f, 0.f, 0.f};
        cur = nxt; cA = nA; cB = nB; ++ui;
        if constexpr (ALIGN_EPI) { if (wr == 1) PG8_BAR; }
    }
    PG8_WAIT_V(0);
    if constexpr (!ALIGN_EPI) { if (wr == 0) PG8_BAR; }
    PG8_BAR;
    if constexpr (Epi::AFTER_DRAIN) { E.fused(acc, cur, wr, wc, fr, fq, lds, wid, lane); S.done(cur); }
#undef PG8_SA
#undef PG8_SB
#undef PG8_STAGE
#undef PG8_LDA
#undef PG8_LDB
#undef PG8_MMA
#undef PG8_WAIT_V
#undef PG8_WAIT_L
#undef PG8_BAR
#undef PG8_SCHED
}
}

constexpr int NWAVES = 8;
constexpr int DM = 1024, MP = 16384, MS = 1024, M = MP + MS, DIN = 4608, DFF = 4096, SEQ = 8192, PAST = 1024, DSEQ = 64;
constexpr int C_Q = 0, C_K = 512, C_V = 1024, C_U = 1536, C_GR = 2048, C_GA = 2560, C_GB = 3584;
constexpr float EPS = 1e-6f;
constexpr float LOG2E = 1.4426950408889634f, LN2 = 0.6931471805599453f;
constexpr size_t MiB = 1u << 20;
constexpr size_t WS_CTL = 0;
constexpr size_t WS_WIN = 1 * MiB, WS_WA = 10 * MiB, WS_WB = 11 * MiB, WS_WO = 12 * MiB, WS_WUP = 14 * MiB, WS_WDN = 22 * MiB;
constexpr size_t WS_WR = 30 * MiB, WS_WI = 30 * MiB + 65536;
constexpr size_t WS_AGA = 31 * MiB, WS_AGB = 31 * MiB + 524288;
constexpr size_t WS_XN = 32 * MiB;
constexpr size_t WS_YA = 66 * MiB;
constexpr size_t WS_PROJ = 100 * MiB;
constexpr size_t WS_DOWN = WS_XN;
constexpr size_t WS_PARTC = WS_PROJ + 64 * MiB;
constexpr size_t WS_PARTD = 236 * MiB;
constexpr size_t WS_END = 253 * MiB;
constexpr int RING_BYTES = 131072, LDSCTL_OFF = RING_BYTES, MISC_OFF = LDSCTL_OFF + 320, LDS_BYTES = 147456;
constexpr int CW_BAR = 4096;
constexpr size_t CTL_ZERO_BYTES = 1u << 20;

#define GAS __attribute__((address_space(1)))
#define LAS __attribute__((address_space(3)))
#define DI __device__ __forceinline__
typedef unsigned short bf16;
typedef unsigned v4u __attribute__((ext_vector_type(4)));
typedef float f32x4 __attribute__((ext_vector_type(4)));
typedef float f32x16 __attribute__((ext_vector_type(16)));
typedef short bf16x8 __attribute__((ext_vector_type(8)));
typedef float f32x2_t __attribute__((ext_vector_type(2))); typedef __bf16 bf16x2_t __attribute__((ext_vector_type(2)));
DI unsigned pk2(float lo, float hi) { f32x2_t v = {lo, hi}; bf16x2_t b = __builtin_convertvector(v, bf16x2_t); return __builtin_bit_cast(unsigned, b); }
DI float bf2f(unsigned short h) { return __uint_as_float((unsigned)h << 16); }
DI float blo(unsigned w) { return __uint_as_float(w << 16); }
DI float bhi(unsigned w) { return __uint_as_float(w & 0xffff0000u); }
DI int crow(int i, int h) { return (i & 3) + 8 * (i >> 2) + 4 * h; }
#define MFMA32(a, b, c) __builtin_amdgcn_mfma_f32_32x32x16_bf16((a), (b), (c), 0, 0, 0)
DI void swap32(float v, float& lo, float& hi) { auto rr = __builtin_amdgcn_permlane32_swap(__float_as_uint(v), __float_as_uint(v), false, false); lo = __uint_as_float(rr[0]); hi = __uint_as_float(rr[1]); }
DI float sigm(float x) { return __builtin_amdgcn_rcpf(1.0f + __builtin_amdgcn_exp2f(-LOG2E * x)); }
DI float wave_sum(float v) {
#pragma unroll
    for (int o = 1; o < 64; o <<= 1) v += __shfl_xor(v, o);
    return v;
}

#define RLX_AGENT __ATOMIC_RELAXED, __HIP_MEMORY_SCOPE_AGENT
#define XB_TMO      128
#define XB_XCNT(j)  (256  + 64 * (j))
#define XB_XSUB(j)  (1280 + 64 * (j))
#define XB_XGEN(j)  (2304 + 64 * (j))
#define XB_TOP      3328
#define XB_TOPGEN   3392
#define XCD_BAR_WORDS 3456
#define XB_SPIN_CAP (1u << 18)

__device__ __forceinline__ unsigned xb_ld(unsigned* p)              { return __hip_atomic_load(p, __ATOMIC_RELAXED, __HIP_MEMORY_SCOPE_AGENT); }
__device__ __forceinline__ unsigned xb_add(unsigned* p, unsigned v) { return __hip_atomic_fetch_add(p, v, __ATOMIC_RELAXED, __HIP_MEMORY_SCOPE_AGENT); }
__device__ __forceinline__ unsigned xb_xcc_id() { return (unsigned)__builtin_amdgcn_s_getreg((3 << 11) | 20) & 0xFu; }
#define XB_SPIN(cond, bar) do { unsigned _sp = 0; while (cond) { __builtin_amdgcn_s_sleep(1); \
    if ((++_sp & 255u) == 0u) { if (xb_ld(&(bar)[XB_TMO])) break; if (_sp > XB_SPIN_CAP) { atomicAdd(&(bar)[XB_TMO], 1u); break; } } } } while (0)

struct XcdBarrier {
    unsigned* bar; unsigned x;
    volatile LAS unsigned* st;
};

__device__ __forceinline__ XcdBarrier xcd_barrier_post(unsigned* bar, volatile LAS unsigned* st) {
    XcdBarrier b; b.bar = bar; b.x = xb_xcc_id(); b.st = st;
    if (threadIdx.x == 0) (void)xb_add(&bar[XB_XCNT(b.x)], 1u);
    return b;
}
__device__ __forceinline__ void xcd_barrier_complete(unsigned* bar, unsigned x, unsigned& nloc, unsigned& nx) {
    const unsigned G = gridDim.x * gridDim.y * gridDim.z;
    unsigned sum, cnt, mine, sp = 0u;
    for (;;) {
        sum = 0u; cnt = 0u; mine = 0u;
#pragma unroll
        for (unsigned j = 0; j < 16; ++j) { const unsigned c = xb_ld(&bar[XB_XCNT(j)]); sum += c; cnt += (c > 0u) ? 1u : 0u; mine = (j == x) ? c : mine; }
        if (sum == G) break;
        __builtin_amdgcn_s_sleep(1);
        if ((++sp & 255u) == 0u) { if (xb_ld(&bar[XB_TMO])) break; if (sp > XB_SPIN_CAP) { atomicAdd(&bar[XB_TMO], 1u); break; } }
    }
    nloc = mine > 0u ? mine : 1u; nx = cnt > 0u ? cnt : 1u;
}

__device__ __forceinline__ void xcd_barrier(const XcdBarrier& b) {
    asm volatile("s_waitcnt vmcnt(0)" ::: "memory");
    __syncthreads();
    if (threadIdx.x == 0) {
        unsigned* bar = b.bar;
        __builtin_amdgcn_s_waitcnt(0);
        unsigned nloc = b.st[0], nx = b.st[1];
        if (nloc == 0u) { xcd_barrier_complete(bar, b.x, nloc, nx); b.st[0] = nloc; b.st[1] = nx; }
        const unsigned old = xb_add(&bar[XB_XSUB(b.x)], 1u);
        const unsigned gen = old / nloc;
        if (old + 1u == (gen + 1u) * nloc) {
            __builtin_amdgcn_fence(__ATOMIC_RELEASE, "agent");
            asm volatile("s_waitcnt vmcnt(0)" ::: "memory");
            const unsigned og = xb_add(&bar[XB_TOP], 1u);
            const unsigned tg = og / nx;
            if (og + 1u == (tg + 1u) * nx) xb_add(&bar[XB_TOPGEN], 1u);
            else XB_SPIN(xb_ld(&bar[XB_TOPGEN]) == tg, bar);
            __builtin_amdgcn_fence(__ATOMIC_ACQUIRE, "agent");
            xb_add(&bar[XB_XGEN(b.x)], 1u);
            asm volatile("s_waitcnt vmcnt(0)" ::: "memory");
        } else {
            XB_SPIN(xb_ld(&bar[XB_XGEN(b.x)]) == gen, bar);
            __builtin_amdgcn_fence(__ATOMIC_ACQUIRE, "agent");
            asm volatile("s_waitcnt vmcnt(0)" ::: "memory");
        }
    }
    __syncthreads();
}

struct Params { const float* in[23]; float* out; unsigned char* ws; };
enum { I_XP = 0, I_XS, I_CK, I_CV, I_SC, I_SH, I_WIN, I_GPM, I_WC, I_BC, I_WR, I_BR, I_WI, I_BI, I_LAM, I_WA, I_WB, I_WO, I_GPOM, I_GPF, I_WUP, I_WDN, I_GPOF };

DI void p0_transpose_item(const float* W, int K, int N, bf16* WT, int ldt, LAS float* scr, int item, int lane) {
    const int nblk = N / 32, kb = item / nblk, nb = item % nblk, k0 = 64 * kb, n0 = 32 * nb;
#pragma unroll 8
    for (int i = 0; i < 32; ++i) { const int kk = 2 * i + (lane >> 5); scr[kk * 33 + (lane & 31)] = W[(size_t)(k0 + kk) * N + n0 + (lane & 31)]; }
    asm volatile("s_waitcnt lgkmcnt(0)" ::: "memory");
    const int c = lane & 7;
#pragma unroll
    for (int j = 0; j < 4; ++j) { const int n = (lane >> 3) + 8 * j; const LAS float* s = scr + (8 * c) * 33 + n;
        v4u o; o.x = pk2(s[0 * 33], s[1 * 33]); o.y = pk2(s[2 * 33], s[3 * 33]); o.z = pk2(s[4 * 33], s[5 * 33]); o.w = pk2(s[6 * 33], s[7 * 33]);
        *(v4u*)(WT + (size_t)(n0 + n) * ldt + k0 + 8 * c) = o; }
    asm volatile("s_waitcnt lgkmcnt(0)" ::: "memory");
}
DI const float* xrow_ptr(const Params& p, int m) { return m < MP ? p.in[I_XP] + (size_t)m * DM : p.in[I_XS] + (size_t)(m - MP) * DM; }
DI void rms_row_to_bf16(const float* xrow, const float* g, bf16* orow, int lane) {
    const f32x4* xr = (const f32x4*)xrow + lane; const f32x4* gr = (const f32x4*)g + lane;
    f32x4 v[4]; float s = 0.f;
#pragma unroll
    for (int j = 0; j < 4; ++j) { v[j] = xr[64 * j]; s += (v[j].x * v[j].x + v[j].y * v[j].y) + (v[j].z * v[j].z + v[j].w * v[j].w); }
    const float sc = 1.0f / sqrtf(wave_sum(s) * (1.f / DM) + EPS);
    unsigned long long* o8 = (unsigned long long*)orow + lane;
#pragma unroll
    for (int j = 0; j < 4; ++j) { const f32x4 gg = gr[64 * j]; o8[64 * j] = (unsigned long long)pk2(v[j].x * sc * gg.x, v[j].y * sc * gg.y) | ((unsigned long long)pk2(v[j].z * sc * gg.z, v[j].w * sc * gg.w) << 32); }
}
DI void p0_prologue(const Params& p, LAS unsigned char* lds, int gw, int NGW, int wave, int lane) {
    LAS float* scr = (LAS float*)(lds + wave * 16384);
    unsigned char* ws = p.ws;
    constexpr int I_IN = (DM / 64) * (DIN / 32), I_A = (512 / 64) * (DM / 32), I_O = (DM / 64) * (DM / 32), I_UP = (DM / 64) * (DFF / 32), I_DN = (DFF / 64) * (DM / 32), I_G = 16;
    constexpr int NITEMS = I_IN + 2 * I_A + I_O + I_UP + I_DN + 2 * I_G;
    for (int it = gw; it < NITEMS; it += NGW) {
        int r = it;
        if (r < I_IN) { p0_transpose_item(p.in[I_WIN], DM, DIN, (bf16*)(ws + WS_WIN), DM, scr, r, lane); continue; } r -= I_IN;
        if (r < I_A) { p0_transpose_item(p.in[I_WA], 512, DM, (bf16*)(ws + WS_WA), DM, scr, r, lane); continue; } r -= I_A;
        if (r < I_A) { p0_transpose_item(p.in[I_WB], 512, DM, (bf16*)(ws + WS_WA) + 512, DM, scr, r, lane); continue; } r -= I_A;
        if (r < I_O) { p0_transpose_item(p.in[I_WO], DM, DM, (bf16*)(ws + WS_WO), DM, scr, r, lane); continue; } r -= I_O;
        if (r < I_UP) { p0_transpose_item(p.in[I_WUP], DM, DFF, (bf16*)(ws + WS_WUP), DM, scr, r, lane); continue; } r -= I_UP;
        if (r < I_DN) { p0_transpose_item(p.in[I_WDN], DFF, DM, (bf16*)(ws + WS_WDN), DFF, scr, r, lane); continue; } r -= I_DN;
        if (r < I_G) { p0_transpose_item(p.in[I_WR] + (r >> 1) * 4096, 64, 64, (bf16*)(ws + WS_WR) + (r >> 1) * 4096, 64, scr, r & 1, lane); continue; } r -= I_G;
        p0_transpose_item(p.in[I_WI] + (r >> 1) * 4096, 64, 64, (bf16*)(ws + WS_WI) + (r >> 1) * 4096, 64, scr, r & 1, lane);
    }
    bf16* XN = (bf16*)(ws + WS_XN);
    for (int m = gw; m < M; m += NGW) rms_row_to_bf16(xrow_ptr(p, m), p.in[I_GPM], XN + (size_t)m * DM, lane);
}

DI void attn_load_kv(const Params& p, const bf16* PROJ, bool from_proj, size_t krow0, int b, int h, int p0, int r, int hh, bf16x8 (&kf)[4], bf16x8 (&vf)[2][2]) {
    if (from_proj) {
        const bf16* kr = PROJ + (krow0 + p0 + r) * pg8::PROJ_LD + C_K + h * 64 + 8 * hh;
#pragma unroll
        for (int s = 0; s < 4; ++s) kf[s] = *(const bf16x8*)(kr + 16 * s);
        const bf16* vb = PROJ + (krow0 + p0) * pg8::PROJ_LD + C_V + h * 64 + r;
#pragma unroll
        for (int s = 0; s < 2; ++s)
#pragma unroll
            for (int j = 0; j < 8; ++j) { const int key = 16 * s + 8 * (j >> 2) + 4 * hh + (j & 3); const bf16* vp = vb + (size_t)key * pg8::PROJ_LD;
                vf[s][0][j] = (short)vp[0]; vf[s][1][j] = (short)vp[32]; }
    } else {
        const float* kr = p.in[I_CK] + ((size_t)(b * PAST + p0 + r) * 8 + h) * 64 + 8 * hh;
#pragma unroll
        for (int s = 0; s < 4; ++s) { const f32x4 a = *(const f32x4*)(kr + 16 * s), c = *(const f32x4*)(kr + 16 * s + 4);
            v4u w; w.x = pk2(a.x, a.y); w.y = pk2(a.z, a.w); w.z = pk2(c.x, c.y); w.w = pk2(c.z, c.w); kf[s] = __builtin_bit_cast(bf16x8, w); }
        const float* vb = p.in[I_CV] + ((size_t)(b * PAST + p0) * 8 + h) * 64 + r;
#pragma unroll
        for (int s = 0; s < 2; ++s) { float t0[8], t1[8];
#pragma unroll
            for (int j = 0; j < 8; ++j) { const int key = 16 * s + 8 * (j >> 2) + 4 * hh + (j & 3); const float* vp = vb + (size_t)key * 512; t0[j] = vp[0]; t1[j] = vp[32]; }
            v4u w0, w1; w0.x = pk2(t0[0], t0[1]); w0.y = pk2(t0[2], t0[3]); w0.z = pk2(t0[4], t0[5]); w0.w = pk2(t0[6], t0[7]);
            w1.x = pk2(t1[0], t1[1]); w1.y = pk2(t1[2], t1[3]); w1.z = pk2(t1[4], t1[5]); w1.w = pk2(t1[6], t1[7]);
            vf[s][0] = __builtin_bit_cast(bf16x8, w0); vf[s][1] = __builtin_bit_cast(bf16x8, w1); }
    }
}
DI void attn_tile(const Params& p, int tile, int lane) {
    const bf16* PROJ = (const bf16*)(p.ws + WS_PROJ); bf16* OH = (bf16*)(p.ws + WS_XN);
    const int r = lane & 31, hh = lane >> 5;
    const bool samp = tile >= 4096;
    int b, h, pos0; size_t qrow0;
    if (!samp) { const int bh = tile >> 8; b = bh >> 3; h = bh & 7; pos0 = (tile & 255) * 32; qrow0 = (size_t)b * SEQ + pos0; }
    else { const int s = tile - 4096, bh = s >> 1; b = bh >> 3; h = bh & 7; pos0 = PAST + 32 * (s & 1); qrow0 = (size_t)MP + b * DSEQ + (pos0 - PAST); }
    const size_t krow0 = qrow0 - pos0;
    const int kb_hi = pos0 >> 5;
    bf16x8 kf[4], vf[2][2];
    attn_load_kv(p, PROJ, true, krow0, b, h, kb_hi * 32, r, hh, kf, vf);
    bf16x8 qf[4];
#pragma unroll
    for (int s = 0; s < 4; ++s) qf[s] = *(const bf16x8*)(PROJ + (qrow0 + r) * pg8::PROJ_LD + C_Q + h * 64 + 16 * s + 8 * hh);
    f32x16 o0, o1;
#pragma unroll
    for (int i = 0; i < 16; ++i) { o0[i] = 0.f; o1[i] = 0.f; }
    float R = 0.f;
    for (int kb = kb_hi; kb >= 0; --kb) {
        bf16x8 kn[4], vn[2][2];
        if (kb > 0) attn_load_kv(p, PROJ, !samp || (kb - 1) * 32 >= PAST, krow0, b, h, (kb - 1) * 32, r, hh, kn, vn);
        f32x16 st;
#pragma unroll
        for (int i = 0; i < 16; ++i) st[i] = 0.f;
#pragma unroll
        for (int s = 0; s < 4; ++s) st = MFMA32(kf[s], qf[s], st);
        const bool diag = (kb == kb_hi);
        float z[16], L[16];
#pragma unroll
        for (int i = 0; i < 16; ++i) { z[i] = st[i] * 0.125f;
            const float e = __builtin_amdgcn_exp2f(-fabsf(z[i]) * LOG2E);
            const float sp = fmaxf(z[i], 0.f) + LN2 * __builtin_amdgcn_logf(1.0f + e);
            const bool valid = !diag || (crow(i, hh) < r);
            L[i] = valid ? -sp : 0.f; }
        float Te[4], To[4];
#pragma unroll
        for (int g = 0; g < 4; ++g) { const float T = (L[4 * g] + L[4 * g + 1]) + (L[4 * g + 2] + L[4 * g + 3]); swap32(T, Te[g], To[g]); }
        float So[4], Sv[4]; So[3] = 0.f; Sv[3] = To[3]; So[2] = Sv[3] + Te[3]; Sv[2] = So[2] + To[2]; So[1] = Sv[2] + Te[2]; Sv[1] = So[1] + To[1]; So[0] = Sv[1] + Te[1]; Sv[0] = So[0] + To[0];
        const float total = Sv[0] + Te[0];
        float w[16];
#pragma unroll
        for (int g = 0; g < 4; ++g) { float run = R + (So[g] + (hh ? 0.f : To[g]));
#pragma unroll
            for (int q = 3; q >= 0; --q) { const int i = 4 * g + q; run += L[i];
                const bool valid = !diag || (crow(i, hh) < r);
                w[i] = valid ? __builtin_amdgcn_exp2f((z[i] + run) * LOG2E) : 0.f; } }
        R += total;
#pragma unroll
        for (int s = 0; s < 2; ++s) { v4u x; x.x = pk2(w[8 * s], w[8 * s + 1]); x.y = pk2(w[8 * s + 2], w[8 * s + 3]); x.z = pk2(w[8 * s + 4], w[8 * s + 5]); x.w = pk2(w[8 * s + 6], w[8 * s + 7]);
            const bf16x8 xs = __builtin_bit_cast(bf16x8, x);
            o0 = MFMA32(xs, vf[s][0], o0); o1 = MFMA32(xs, vf[s][1], o1); }
        if (__all(R < -110.f)) break;
        if (kb > 0) {
#pragma unroll
            for (int s = 0; s < 4; ++s) kf[s] = kn[s];
#pragma unroll
            for (int s = 0; s < 2; ++s) { vf[s][0] = vn[s][0]; vf[s][1] = vn[s][1]; } }
    }
    bf16* ob = OH + qrow0 * DM + h * 64 + r;
#pragma unroll
    for (int i = 0; i < 16; ++i) { bf16* op = ob + (size_t)crow(i, hh) * DM; op[0] = (bf16)(pk2(o0[i], 0.f) & 0xffffu); op[32] = (bf16)(pk2(o1[i], 0.f) & 0xffffu); }
}

template <int PASS> DI void scan_unit(const Params& p, int unit, LAS float* scr, int lane) {
    const bf16* PROJ = (const bf16*)(p.ws + WS_PROJ); bf16* OH = (bf16*)(p.ws + WS_XN);
    float* AGA = (float*)(p.ws + WS_AGA); float* AGB = (float*)(p.ws + WS_AGB);
    const int r = lane & 31, hh = lane >> 5;
    const bool samp = unit >= 2048;
    int b, c, n; size_t row0;
    if (!samp) { b = unit >> 10; c = (unit >> 3) & 127; n = unit & 7; row0 = (size_t)b * SEQ + c * 64; }
    else { const int s = unit - 2048; b = s >> 3; c = 0; n = s & 7; row0 = (size_t)MP + b * DSEQ; }
    const int ch0 = n * 64;
#pragma unroll 2
    for (int s4 = 0; s4 < 4; ++s4) { const int c0 = 16 * s4 + 8 * hh;
        const f32x4 b0 = *(const f32x4*)(p.in[I_BC] + ch0 + c0), b1 = *(const f32x4*)(p.in[I_BC] + ch0 + c0 + 4);
        f32x4 wc0[4], wc1[4];
#pragma unroll
        for (int j = 0; j < 4; ++j) { const float* wp = p.in[I_WC] + j * 512 + ch0 + c0; wc0[j] = *(const f32x4*)wp; wc1[j] = *(const f32x4*)(wp + 4); }
#pragma unroll
        for (int tb = 0; tb < 2; ++tb) { const int t = 32 * tb + r;
            f32x4 a0 = b0, a1 = b1;
#pragma unroll
            for (int j = 0; j < 4; ++j) { const int tt = t - 3 + j; f32x4 x0, x1;
                if (tt >= 0 || c > 0) { const v4u xv = *(const v4u*)(PROJ + (row0 + tt) * pg8::PROJ_LD + C_U + ch0 + c0);
                    x0 = (f32x4){blo(xv.x), bhi(xv.x), blo(xv.y), bhi(xv.y)}; x1 = (f32x4){blo(xv.z), bhi(xv.z), blo(xv.w), bhi(xv.w)}; }
                else if (samp) { const float* sp = p.in[I_SC] + (size_t)(b * 3 + 3 + tt) * 512 + ch0 + c0; x0 = *(const f32x4*)sp; x1 = *(const f32x4*)(sp + 4); }
                else { x0 = (f32x4){0.f, 0.f, 0.f, 0.f}; x1 = x0; }
                a0 += x0 * wc0[j]; a1 += x1 * wc1[j]; }
            const int q0 = c0 >> 2, sw = t & 15;
            *(LAS f32x4*)(scr + t * 64 + ((q0 ^ sw) << 2)) = a0;
            *(LAS f32x4*)(scr + t * 64 + (((q0 + 1) ^ sw) << 2)) = a1; } }
    float hc = 0.f;
    if (PASS == 2) {
        if (samp) hc = p.in[I_SH][b * 512 + ch0 + lane];
        else { const float* pa = AGA + (size_t)b * 128 * 512 + ch0 + lane; const float* pb = AGB + (size_t)b * 128 * 512 + ch0 + lane;
            int cc = 0;
            for (; cc + 16 <= c; cc += 16) { float ta[16], tb_[16];
#pragma unroll
                for (int k = 0; k < 16; ++k) { ta[k] = pa[(size_t)(cc + k) * 512]; tb_[k] = pb[(size_t)(cc + k) * 512]; }
#pragma unroll
                for (int k = 0; k < 16; ++k) hc = ta[k] * hc + tb_[k]; }
            for (; cc < c; ++cc) hc = pa[(size_t)cc * 512] * hc + pb[(size_t)cc * 512]; }
    }
    const bf16* WRT = (const bf16*)(p.ws + WS_WR) + n * 4096; const bf16* WIT = (const bf16*)(p.ws + WS_WI) + n * 4096;
#pragma unroll 1
    for (int db = 0; db < 2; ++db) { const int d = 32 * db + r;
        bf16x8 wr[4], wi[4];
#pragma unroll
        for (int s = 0; s < 4; ++s) { wr[s] = *(const bf16x8*)(WRT + d * 64 + 16 * s + 8 * hh); wi[s] = *(const bf16x8*)(WIT + d * 64 + 16 * s + 8 * hh); }
        const float br = p.in[I_BR][ch0 + d], bi = p.in[I_BI][ch0 + d], lam = p.in[I_LAM][ch0 + d];
        const float cl = -8.0f * (fmaxf(-lam, 0.f) + log1pf(expf(-fabsf(lam))));
        float car = (PASS == 2) ? __shfl(hc, d) : 0.f, agA = 1.f, agB = 0.f;
#pragma unroll 1
        for (int tb = 0; tb < 2; ++tb) {
            f32x16 aR, aI;
#pragma unroll
            for (int i = 0; i < 16; ++i) { aR[i] = 0.f; aI[i] = 0.f; }
            unsigned short grv[16];
            if (PASS == 2) {
#pragma unroll
                for (int i = 0; i < 16; ++i) grv[i] = PROJ[(row0 + 32 * tb + crow(i, hh)) * pg8::PROJ_LD + C_GR + ch0 + d]; }
            { const int t = 32 * tb + r, sw = t & 15;
#pragma unroll
              for (int s = 0; s < 4; ++s) { const int q0 = (16 * s + 8 * hh) >> 2;
                const f32x4 x0 = *(const LAS f32x4*)(scr + t * 64 + ((q0 ^ sw) << 2)), x1 = *(const LAS f32x4*)(scr + t * 64 + (((q0 + 1) ^ sw) << 2));
                v4u w; w.x = pk2(x0.x, x0.y); w.y = pk2(x0.z, x0.w); w.z = pk2(x1.x, x1.y); w.w = pk2(x1.z, x1.w); const bf16x8 af = __builtin_bit_cast(bf16x8, w);
                aR = MFMA32(af, wr[s], aR); aI = MFMA32(af, wi[s], aI); } }
            float av[16], uv[16];
#pragma unroll
            for (int i = 0; i < 16; ++i) { const int t = 32 * tb + crow(i, hh);
                const float rg = sigm(aR[i] + br), ig = sigm(aI[i] + bi);
                const float la = cl * rg;
                av[i] = __builtin_amdgcn_exp2f(la * LOG2E);
                const float ucv = scr[t * 64 + (((d >> 2) ^ (t & 15)) << 2) + (d & 3)];
                const float x2 = 2.0f * la;
                const float om = (x2 > -0.125f) ? -x2 * (1.0f + x2 * (0.5f + x2 * (0.16666667f + x2 * (0.041666668f + x2 * 0.0083333338f)))) : 1.0f - av[i] * av[i];
                uv[i] = __builtin_amdgcn_sqrtf(om) * (ig * ucv); }
#pragma unroll
            for (int g = 0; g < 4; ++g) {
                float Ag = 1.f, Bg = 0.f;
#pragma unroll
                for (int q = 0; q < 4; ++q) { Bg = av[4 * g + q] * Bg + uv[4 * g + q]; Ag *= av[4 * g + q]; }
                float Al, Ah, Bl, Bh; swap32(Ag, Al, Ah); swap32(Bg, Bl, Bh);
                if (PASS == 1) { agB = Al * agB + Bl; agA *= Al; agB = Ah * agB + Bh; agA *= Ah; }
                else { const float hs_hi = Al * car + Bl; float hv = hh ? hs_hi : car;
#pragma unroll
                    for (int q = 0; q < 4; ++q) { const int i = 4 * g + q; const int t = 32 * tb + crow(i, hh);
                        hv = av[i] * hv + uv[i];
                        const float gr = bf2f(grv[i]);
                        const float ge = gr * sigm(1.5957691216057308f * (gr + 0.044715f * gr * gr * gr));
                        OH[(row0 + t) * DM + 512 + ch0 + d] = (bf16)(pk2(hv * ge, 0.f) & 0xffffu); }
                    car = Ah * hs_hi + Bh; }
            }
        }
        if (PASS == 1) { if (hh == 0) { AGA[((size_t)b * 128 + c) * 512 + ch0 + d] = agA; AGB[((size_t)b * 128 + c) * 512 + ch0 + d] = agB; } }
        else if (hh == 0 && (samp || c == 127)) { p.out[(samp ? pg8::OFF_HS : pg8::OFF_HP) + (size_t)b * 512 + ch0 + d] = car; }
    }
    if (PASS == 2 && (samp || c == 127)) {
#pragma unroll
        for (int j = 0; j < 3; ++j) p.out[(samp ? pg8::OFF_CS : pg8::OFF_CP) + (size_t)(b * 3 + j) * 512 + ch0 + lane] = bf2f(PROJ[(row0 + 61 + j) * pg8::PROJ_LD + C_U + ch0 + lane]);
    }
}

DI void norm_a_row(const Params& p, int m, int lane) {
    const f32x4* xr = (const f32x4*)xrow_ptr(p, m) + lane; const f32x4* mr = (const f32x4*)((const float*)(p.ws + WS_PROJ) + (size_t)m * DM) + lane;
    const f32x4* g1 = (const f32x4*)p.in[I_GPOM] + lane; const f32x4* g2 = (const f32x4*)p.in[I_GPF] + lane;
    f32x4 v[4], x1[4]; float s = 0.f;
#pragma unroll
    for (int j = 0; j < 4; ++j) { if (m < MP) v[j] = mr[64 * j]; else { const f32x4* pr = (const f32x4*)((const float*)(p.ws + WS_PARTC) + (size_t)(m - MP) * DM) + lane + 64 * j; v[j] = (pr[0] + pr[262144]) + (pr[524288] + pr[786432]); }
        s += (v[j].x * v[j].x + v[j].y * v[j].y) + (v[j].z * v[j].z + v[j].w * v[j].w); }
    const float sc = 1.0f / sqrtf(wave_sum(s) * (1.f / DM) + EPS); float s2 = 0.f;
    f32x4* yo = (f32x4*)(p.out + pg8::OFF_Y + (size_t)m * DM) + lane;
#pragma unroll
    for (int j = 0; j < 4; ++j) { x1[j] = xr[64 * j] + v[j] * sc * g1[64 * j]; yo[64 * j] = x1[j]; s2 += (x1[j].x * x1[j].x + x1[j].y * x1[j].y) + (x1[j].z * x1[j].z + x1[j].w * x1[j].w); }
    const float sc2 = 1.0f / sqrtf(wave_sum(s2) * (1.f / DM) + EPS);
    unsigned long long* o8 = (unsigned long long*)((bf16*)(p.ws + WS_XN) + (size_t)m * DM) + lane;
#pragma unroll
    for (int j = 0; j < 4; ++j) { const f32x4 gg = g2[64 * j]; o8[64 * j] = (unsigned long long)pk2(x1[j].x * sc2 * gg.x, x1[j].y * sc2 * gg.y) | ((unsigned long long)pk2(x1[j].z * sc2 * gg.z, x1[j].w * sc2 * gg.w) << 32); }
}
DI void norm_b_row(const Params& p, int m, int lane) {
    const f32x4* dr = (const f32x4*)((const float*)(p.ws + WS_DOWN) + (size_t)m * DM) + lane; const f32x4* g = (const f32x4*)p.in[I_GPOF] + lane;
    f32x4* yo = (f32x4*)(p.out + pg8::OFF_Y + (size_t)m * DM) + lane;
    f32x4 v[4]; float s = 0.f;
#pragma unroll
    for (int j = 0; j < 4; ++j) { if (m < MP) v[j] = dr[64 * j]; else { const f32x4* pr = (const f32x4*)((const float*)(p.ws + WS_PARTD) + (size_t)(m - MP) * DM) + lane + 64 * j; v[j] = (pr[0] + pr[262144]) + (pr[524288] + pr[786432]); }
        s += (v[j].x * v[j].x + v[j].y * v[j].y) + (v[j].z * v[j].z + v[j].w * v[j].w); }
    const float sc = 1.0f / sqrtf(wave_sum(s) * (1.f / DM) + EPS);
#pragma unroll
    for (int j = 0; j < 4; ++j) yo[64 * j] = yo[64 * j] + v[j] * sc * g[64 * j];
}

__global__ void __launch_bounds__(NWAVES * 64, 2) fwd_mega(Params p) {
    extern __shared__ __attribute__((aligned(16))) unsigned char lds_raw[];
    cg::grid_group grid = cg::this_grid();
    LAS unsigned char* lds = (LAS unsigned char*)lds_raw;
    const int tid = threadIdx.x, lane = tid & 63, wave = __builtin_amdgcn_readfirstlane(tid >> 6);
    const int G = gridDim.x, bx = blockIdx.x;
    const int vcu = (G % 8 == 0) ? (bx % 8) * (G / 8) + bx / 8 : bx;
    const int gw = vcu * NWAVES + wave, NGW = G * NWAVES;
    unsigned char* ws = p.ws;
    for (int u = tid; u < (LDS_BYTES - LDSCTL_OFF) / 4; u += NWAVES * 64) ((LAS unsigned*)(lds + LDSCTL_OFF))[u] = 0u;
    __syncthreads();
    const XcdBarrier bar = xcd_barrier_post((unsigned*)(ws + WS_CTL) + CW_BAR, (volatile LAS unsigned*)(lds + MISC_OFF) + 8);
    pg8::bf16_t* PROJ = (pg8::bf16_t*)(ws + WS_PROJ); pg8::bf16_t* XN = (pg8::bf16_t*)(ws + WS_XN); pg8::bf16_t* YA = (pg8::bf16_t*)(ws + WS_YA);

    p0_prologue(p, lds, gw, NGW, wave, lane);
    grid.sync();
    { pg8::Gemm g{XN, (const pg8::bf16_t*)(ws + WS_WIN), M, DIN, DM, DM}; pg8::StaticOrder S; S.init(M, DIN, G, bx, 16);
      pg8::EpiProj E{PROJ, p.out};
      pg8::gemm_phase<pg8::EpiProj, pg8::StaticOrder, true, true>(lds, g, S, E); }
    xcd_barrier(bar);
    { LAS float* scr = (LAS float*)(lds + wave * 16384);
      for (int u = gw; u < 2048; u += NGW) scan_unit<1>(p, u, scr, lane);
      for (int t = gw; t < 2048; t += NGW) attn_tile(p, t, lane); }
    xcd_barrier(bar);
    { LAS float* scr = (LAS float*)(lds + wave * 16384);
      for (int u = gw; u < 2176; u += NGW) scan_unit<2>(p, u, scr, lane);
      for (int t = 2048 + gw; t < 4096; t += NGW) attn_tile(p, t, lane);
      if (NGW == 2048) { if (gw >= 1024 && gw < 1280) attn_tile(p, 4096 + (gw - 1024), lane); }
      else for (int t = 4096 + gw; t < 4352; t += NGW) attn_tile(p, t, lane); }
    xcd_barrier(bar);
    { pg8::Gemm g{XN, (const pg8::bf16_t*)(ws + WS_WA), M, DM, DM, DM}; pg8::OrderPair S; S.init(M, DM, G, bx);
      pg8::EpiGate E{YA, PROJ};
      pg8::gemm_phase<pg8::EpiGate, pg8::OrderPair, true, true>(lds, g, S, E); }
    xcd_barrier(bar);
    { pg8::Gemm g{YA, (const pg8::bf16_t*)(ws + WS_WO), M, DM, DM, DM}; pg8::OrderSplit S; S.init(DM, G, bx, 16, 4);
      pg8::EpiF32P E{(float*)(ws + WS_PROJ), (float*)(ws + WS_PARTC)};
      pg8::gemm_phase<pg8::EpiF32P, pg8::OrderSplit, true, true>(lds, g, S, E); }
    xcd_barrier(bar);
    for (int m = gw; m < M; m += NGW) norm_a_row(p, m, lane);
    xcd_barrier(bar);
    { pg8::Gemm g{XN, (const pg8::bf16_t*)(ws + WS_WUP), M, DFF, DM, DM}; pg8::StaticOrder S; S.init(M, DFF, G, bx, 16);
      pg8::EpiRelu2 E{PROJ, DFF};
      pg8::gemm_phase<pg8::EpiRelu2, pg8::StaticOrder, true, true>(lds, g, S, E); }
    xcd_barrier(bar);
    { pg8::Gemm g{PROJ, (const pg8::bf16_t*)(ws + WS_WDN), M, DM, DFF, DFF}; pg8::OrderSplit S; S.init(DM, G, bx, 64, 4);
      pg8::EpiF32P E{(float*)(ws + WS_DOWN), (float*)(ws + WS_PARTD)};
      pg8::gemm_phase<pg8::EpiF32P, pg8::OrderSplit, true, true>(lds, g, S, E); }
    xcd_barrier(bar);
    for (int m = gw; m < M; m += NGW) norm_b_row(p, m, lane);
}

extern "C" void kernel_launch(void* const* d_in, const int* in_sizes, int n_in, void* d_out, int out_size, void* d_ws, size_t ws_size, hipStream_t stream) {
    static int grid = 0;
    if (grid == 0) {
        if (n_in != 23 || in_sizes[0] != MP * DM || (size_t)out_size != pg8::OUT_TOTAL || ws_size < WS_END) { fprintf(stderr, "kernel_launch: unexpected shapes (n_in %d, in0 %d, out %d, ws %zu)\n", n_in, n_in > 0 ? in_sizes[0] : -1, out_size, ws_size); grid = -1; return; }
        int dev = 0, cus = 0, per_cu = 0;
        if (hipGetDevice(&dev) != hipSuccess || hipDeviceGetAttribute(&cus, hipDeviceAttributeMultiprocessorCount, dev) != hipSuccess) { grid = -1; return; }
        if (hipFuncSetAttribute((const void*)fwd_mega, hipFuncAttributeMaxDynamicSharedMemorySize, LDS_BYTES) != hipSuccess) { fprintf(stderr, "kernel_launch: hipFuncSetAttribute failed\n"); grid = -1; return; }
        if (hipOccupancyMaxActiveBlocksPerMultiprocessor(&per_cu, (const void*)fwd_mega, NWAVES * 64, LDS_BYTES) != hipSuccess || per_cu < 1) { fprintf(stderr, "kernel_launch: occupancy query says %d blocks per CU\n", per_cu); per_cu = 1; }
        (void)hipGetLastError();
        grid = cus;
    }
    if (grid < 0) return;
    if (hipMemsetAsync((char*)d_ws + WS_CTL, 0, CTL_ZERO_BYTES, stream) != hipSuccess) { fprintf(stderr, "kernel_launch: hipMemsetAsync failed\n"); return; }
    Params prm{};
    for (int i = 0; i < 23; ++i) prm.in[i] = (const float*)d_in[i];
    prm.out = (float*)d_out; prm.ws = (unsigned char*)d_ws;
    void* args[] = {&prm};
    hipError_t e = hipLaunchCooperativeKernel((const void*)fwd_mega, dim3(grid), dim3(NWAVES * 64), args, LDS_BYTES, stream);
    if (e != hipSuccess) fprintf(stderr, "kernel_launch: cooperative launch failed: %s (grid %d)\n", hipGetErrorString(e), grid);
}
```
